# Optimizing an MI355X kernel written in HIP

```python
import jax, jax.numpy as jnp
from jax import lax
import numpy as np

D_MODEL = 1024
BATCH = 8
SEQ = 2048
DEPTH = 2
DEC_BATCH = 128
DEC_SEQ = 8
PAST_LEN = 16384
PAGE_SIZE = 128

N_HEADS_A = 8
HEAD_DK = 128
HEAD_DV = 128
D_QK = N_HEADS_A * HEAD_DK
D_VA = N_HEADS_A * HEAD_DV
D_CONV = 2 * D_QK + D_VA
CONV_W = 4
DELTA_CHUNK = 64
MLP_CHUNK = 128
N_GROUPS_B = 8
D_B = 1024
GROUP_DIM_B = D_B // N_GROUPS_B
D_FF = ((8 * D_MODEL // 3 + 255) // 256) * 256
SPLIT_POINTS = (D_CONV,
                D_CONV + D_VA,
                D_CONV + D_VA + N_HEADS_A,
                D_CONV + D_VA + 2 * N_HEADS_A,
                D_CONV + D_VA + 2 * N_HEADS_A + 2 * D_B)
D_IN = D_CONV + D_VA + 2 * N_HEADS_A + 2 * D_B + 2 * D_MODEL

kernel_name = "hybrid_gdn_chunkmlp_decoder_step"


def rms_norm(x, w, eps=1e-6):
    xf = x.astype(jnp.float32)
    y = xf * lax.rsqrt(jnp.mean(jnp.square(xf), axis=-1, keepdims=True) + eps)
    return (y * w.astype(jnp.float32)).astype(x.dtype)


def layer_norm(x, w, b, eps=1e-5):
    xf = x.astype(jnp.float32)
    xc = xf - jnp.mean(xf, axis=-1, keepdims=True)
    var = jnp.mean(jnp.square(xc), axis=-1, keepdims=True)
    return (xc * lax.rsqrt(var + eps) * w.astype(jnp.float32) + b.astype(jnp.float32)).astype(x.dtype)


def l2_normalize(x, eps=1e-6):
    xf = x.astype(jnp.float32)
    return xf * lax.rsqrt(jnp.sum(jnp.square(xf), axis=-1, keepdims=True) + eps)


def causal_short_conv(x, buf, w):
    t = x.shape[1]
    xp = jnp.concatenate([buf.astype(x.dtype), x], axis=1)
    y = sum(w[i] * xp[:, i:i + t] for i in range(CONV_W))
    return jax.nn.silu(y), xp[:, -(CONV_W - 1):]


def gated_delta_chunked(q, k, v, g, beta, s0):
    n, t, h, dk = q.shape
    dv = v.shape[-1]
    c = min(DELTA_CHUNK, t)
    pad = (-t) % c
    n_c = (t + pad) // c

    def prep(arr):
        arr = jnp.pad(arr, [(0, 0), (0, pad)] + [(0, 0)] * (arr.ndim - 2))
        arr = arr.reshape((n, n_c, c, h) + arr.shape[3:])
        return jnp.swapaxes(jnp.swapaxes(arr, 0, 1), 2, 3)

    q = prep(q * HEAD_DK ** -0.5)
    k = prep(k)
    v = prep(v)
    g = prep(g)
    beta = prep(beta)
    gc = jnp.cumsum(g, axis=-1)
    idx = jnp.arange(c)
    causal = idx[:, None] >= idx[None, :]
    strict = idx[:, None] > idx[None, :]
    decay = jnp.exp(jnp.where(causal, gc[..., :, None] - gc[..., None, :], -jnp.inf))
    k_beta = k * beta[..., None]
    a_mat = jnp.where(strict, jnp.einsum('mnhik,mnhjk->mnhij', k_beta, k) * decay, 0.0)
    rhs = jnp.concatenate([v * beta[..., None], k_beta * jnp.exp(gc)[..., None]], axis=-1)
    sol = lax.linalg.triangular_solve(a_mat + jnp.eye(c, dtype=jnp.float32), rhs,
                                      left_side=True, lower=True, unit_diagonal=True)
    u, w = sol[..., :dv], sol[..., dv:]
    qk = jnp.einsum('mnhik,mnhjk->mnhij', q, k) * decay

    def step(s, inp):
        q_c, k_c, u_c, w_c, g_c, qk_c = inp
        v_new = u_c - jnp.einsum('nhck,nhkv->nhcv', w_c, s)
        o_c = (jnp.einsum('nhck,nhkv->nhcv', q_c * jnp.exp(g_c)[..., None], s)
               + jnp.einsum('nhij,nhjv->nhiv', qk_c, v_new))
        g_last = g_c[..., -1:]
        s = (s * jnp.exp(g_last)[..., None]
             + jnp.einsum('nhck,nhcv->nhkv', k_c * jnp.exp(g_last - g_c)[..., None], v_new))
        return s, o_c

    s_final, o = lax.scan(step, s0, (q, k, u, w, gc, qk))
    o = jnp.swapaxes(jnp.swapaxes(o, 2, 3), 0, 1).reshape(n, n_c * c, h, dv)[:, :t]
    return o, s_final


def delta_branch(qkv, z, a, b, conv_buf, s0, conv_w, a_log, dt_bias, norm_w):
    n, t, _ = qkv.shape
    qkv_c, new_buf = causal_short_conv(qkv, conv_buf, conv_w)
    q, k, v = jnp.split(qkv_c, [D_QK, 2 * D_QK], axis=-1)
    q = l2_normalize(q.reshape(n, t, N_HEADS_A, HEAD_DK))
    k = l2_normalize(k.reshape(n, t, N_HEADS_A, HEAD_DK))
    v = v.reshape(n, t, N_HEADS_A, HEAD_DV).astype(jnp.float32)
    g = -jnp.exp(a_log.astype(jnp.float32)) * jax.nn.softplus(a.astype(jnp.float32) + dt_bias.astype(jnp.float32))
    beta = jax.nn.sigmoid(b.astype(jnp.float32))
    o, s_new = gated_delta_chunked(q, k, v, g, beta, s0.astype(jnp.float32))
    o = rms_norm(o, norm_w) * jax.nn.silu(z.reshape(n, t, N_HEADS_A, HEAD_DV).astype(jnp.float32))
    return o.reshape(n, t, D_VA).astype(qkv.dtype), new_buf, s_new.astype(s0.dtype)


def chunk_mlp_branch(uv, ln_w, ln_b, w_spatial, b_spatial):
    n, t, _ = uv.shape
    u, v = jnp.split(jax.nn.gelu(uv, approximate=False), 2, axis=-1)
    v = layer_norm(v, ln_w, ln_b)
    c = min(MLP_CHUNK, t)
    pad = (-t) % c
    n_c = (t + pad) // c
    vc = jnp.pad(v, [(0, 0), (0, pad), (0, 0)]).reshape(n, n_c, c, N_GROUPS_B, GROUP_DIM_B)
    idx = jnp.arange(c)
    ws = jnp.where(idx[:, None] >= idx[None, :], w_spatial[:, :c, :c], 0.0)
    mixed = (jnp.einsum('gij,nmjgd->nmigd', ws, vc)
             + jnp.swapaxes(b_spatial[:, :c], 0, 1)[:, :, None])
    mixed = mixed.reshape(n, n_c * c, D_B)[:, :t]
    last_start = ((t - 1) // MLP_CHUNK) * MLP_CHUNK
    return u * mixed, v[:, last_start:]


def trunk_layer(x, conv_buf, s0, norm_pre_mix, w_in, conv_w, a_log, dt_bias, delta_norm_w,
                sgu_ln_w, sgu_ln_b, w_spatial, b_spatial, w_proj_a, w_proj_b, w_out,
                norm_post_mix, norm_pre_ffn, w_ffn_in, w_ffn_out, norm_post_ffn):
    h = rms_norm(x, norm_pre_mix)
    proj = jnp.einsum('btd,de->bte', h, w_in)
    qkv, z, a, b, uv, gates = jnp.split(proj, SPLIT_POINTS, axis=-1)
    o_a, new_buf, s_new = delta_branch(qkv, z, a, b, conv_buf, s0, conv_w, a_log, dt_bias, delta_norm_w)
    o_b, v_rows = chunk_mlp_branch(uv, sgu_ln_w, sgu_ln_b, w_spatial, b_spatial)
    g_a, g_b = jnp.split(gates, 2, axis=-1)
    merged = (jax.nn.sigmoid(g_a) * jnp.einsum('bte,ed->btd', o_a, w_proj_a)
              + jax.nn.sigmoid(g_b) * jnp.einsum('bte,ed->btd', o_b, w_proj_b))
    x = x + rms_norm(jnp.einsum('btd,de->bte', merged, w_out), norm_post_mix)
    h = rms_norm(x, norm_pre_ffn)
    gate, up = jnp.split(jnp.einsum('btd,df->btf', h, w_ffn_in), 2, axis=-1)
    x = x + rms_norm(jnp.einsum('btf,fd->btd', jax.nn.silu(gate) * up, w_ffn_out), norm_post_ffn)
    return x, s_new, new_buf, v_rows


def setup_inputs(seed: int = 0) -> dict:
    key = jax.random.key(seed)
    ks = jax.random.split(key, 24)
    f32 = jnp.float32

    def nrm(k, shape, scale):
        return jax.random.normal(k, shape, f32) * scale

    def gain(k, shape):
        return 1.0 + 0.05 * jax.random.normal(k, shape, f32)

    dt = jax.random.uniform(ks[8], (DEPTH, N_HEADS_A), f32, 0.001, 0.1)
    return {
        "x_prompt": nrm(ks[0], (BATCH, SEQ, D_MODEL), 1.0),
        "x_sample": nrm(ks[1], (DEC_BATCH, DEC_SEQ, D_MODEL), 1.0),
        "state_delta": nrm(ks[2], (DEPTH, DEC_BATCH, N_HEADS_A, HEAD_DK, HEAD_DV), 0.1),
        "state_conv": nrm(ks[3], (DEPTH, DEC_BATCH, CONV_W - 1, D_CONV), 1.0),
        "norm_pre_mix": gain(ks[4], (DEPTH, D_MODEL)),
        "w_in": nrm(ks[5], (DEPTH, D_MODEL, D_IN), D_MODEL ** -0.5),
        "conv_w": nrm(ks[6], (DEPTH, CONV_W, D_CONV), CONV_W ** -0.5),
        "a_log": jnp.log(jax.random.uniform(ks[7], (DEPTH, N_HEADS_A), f32, 1.0, 16.0)),
        "dt_bias": jnp.log(jnp.expm1(dt)),
        "delta_norm_w": gain(ks[9], (DEPTH, HEAD_DV)),
        "sgu_ln_w": gain(ks[10], (DEPTH, D_B)),
        "sgu_ln_b": nrm(ks[11], (DEPTH, D_B), 0.02),
        "w_spatial": nrm(ks[12], (DEPTH, N_GROUPS_B, MLP_CHUNK, MLP_CHUNK), MLP_CHUNK ** -0.5),
        "b_spatial": 1.0 + 0.1 * jax.random.normal(ks[13], (DEPTH, N_GROUPS_B, MLP_CHUNK), f32),
        "w_proj_a": nrm(ks[14], (DEPTH, D_VA, D_MODEL), D_VA ** -0.5),
        "w_proj_b": nrm(ks[15], (DEPTH, D_B, D_MODEL), D_B ** -0.5),
        "w_out": nrm(ks[16], (DEPTH, D_MODEL, D_MODEL), D_MODEL ** -0.5),
        "norm_post_mix": gain(ks[17], (DEPTH, D_MODEL)),
        "norm_pre_ffn": gain(ks[18], (DEPTH, D_MODEL)),
        "w_ffn_in": nrm(ks[19], (DEPTH, D_MODEL, 2 * D_FF), D_MODEL ** -0.5),
        "w_ffn_out": nrm(ks[20], (DEPTH, D_FF, D_MODEL), D_FF ** -0.5),
        "norm_post_ffn": gain(ks[21], (DEPTH, D_MODEL)),
    }


def reference(x_prompt, x_sample, state_delta, state_conv, norm_pre_mix, w_in, conv_w, a_log,
              dt_bias, delta_norm_w, sgu_ln_w, sgu_ln_b, w_spatial, b_spatial, w_proj_a, w_proj_b,
              w_out, norm_post_mix, norm_pre_ffn, w_ffn_in, w_ffn_out, norm_post_ffn):
    y_p, y_s = x_prompt, x_sample
    conv0 = jnp.zeros((BATCH, CONV_W - 1, D_CONV), x_prompt.dtype)
    s_zero = jnp.zeros((BATCH, N_HEADS_A, HEAD_DK, HEAD_DV), state_delta.dtype)
    sd_p, sc_p, cv_p, sd_s, sc_s, cv_s = [], [], [], [], [], []
    for l in range(DEPTH):
        p = dict(norm_pre_mix=norm_pre_mix[l], w_in=w_in[l], conv_w=conv_w[l], a_log=a_log[l],
                 dt_bias=dt_bias[l], delta_norm_w=delta_norm_w[l], sgu_ln_w=sgu_ln_w[l],
                 sgu_ln_b=sgu_ln_b[l], w_spatial=w_spatial[l], b_spatial=b_spatial[l],
                 w_proj_a=w_proj_a[l], w_proj_b=w_proj_b[l], w_out=w_out[l],
                 norm_post_mix=norm_post_mix[l], norm_pre_ffn=norm_pre_ffn[l],
                 w_ffn_in=w_ffn_in[l], w_ffn_out=w_ffn_out[l], norm_post_ffn=norm_post_ffn[l])
        y_p, s_new, buf_new, v_rows = trunk_layer(y_p, conv0, s_zero, **p)
        sd_p.append(s_new)
        sc_p.append(buf_new)
        cv_p.append(v_rows)
        y_s, s_new, buf_new, v_rows = trunk_layer(y_s, state_conv[l], state_delta[l], **p)
        sd_s.append(s_new)
        sc_s.append(buf_new)
        cv_s.append(v_rows)
    return (y_p, y_s, jnp.stack(sd_p), jnp.stack(sc_p), jnp.stack(cv_p),
            jnp.stack(sd_s), jnp.stack(sc_s), jnp.stack(cv_s))
```

```cpp
#include <hip/hip_runtime.h>
#include <hip/hip_cooperative_groups.h>
#include <cstdio>
#include <cstdint>
namespace cg = cooperative_groups;

#ifndef MK_ONE_LAUNCH
#define MK_ONE_LAUNCH 0
#endif

constexpr int NWAVES = 8;
constexpr int DM = 1024, NB = 8, SEQ = 2048, DEPTH = 2, NS = 128, TS_ = 8, NH = 8, HD = 128, DCONV = 3072, DB = 1024, DFF = 2816, DIN = 8208;
constexpr int TP = NB * SEQ, TSM = NS * TS_, TT = TP + TSM;
constexpr size_t O_YP = 0, O_YS = (size_t)TP * DM, O_SDP = O_YS + (size_t)TSM * DM, O_SCP = O_SDP + (size_t)DEPTH * NB * NH * HD * HD,
                 O_CVP = O_SCP + (size_t)DEPTH * NB * 3 * DCONV, O_SDS = O_CVP + (size_t)DEPTH * NB * 128 * DB, O_SCS = O_SDS + (size_t)DEPTH * NS * NH * HD * HD,
                 O_CVS = O_SCS + (size_t)DEPTH * NS * 3 * DCONV, O_END = O_CVS + (size_t)DEPTH * NS * TS_ * DB;
constexpr size_t MiB = 1u << 20;
constexpr size_t WS_CTL = 0, WS_AB = 1 * MiB, WS_RSTD = 3 * MiB, WS_W = 4 * MiB, W_LAYER = 40 * MiB;
constexpr size_t W_IN = 0, W_PAB = 16 * MiB, W_OUT = 20 * MiB, W_FIN = 22 * MiB, W_FOUT = 33 * MiB, W_AB = 39 * MiB;
constexpr size_t WS_XB = 84 * MiB, WS_A = 118 * MiB, WS_B = 220 * MiB, WS_C = 322 * MiB, WS_D = 356 * MiB, WS_E = 424 * MiB, WS_END = 492 * MiB;
constexpr int LDS_BYTES = 147456;

namespace pg8 {
#define PG8_LAS __attribute__((address_space(3)))
typedef unsigned short bf16_t;
typedef short bf16x8 __attribute__((ext_vector_type(8)));
typedef float f32x4 __attribute__((ext_vector_type(4)));
typedef unsigned u32x4 __attribute__((ext_vector_type(4)));
constexpr int BM = 256, BK = 64, HALF = 128, HTB = HALF * BK * 2, STAGE_BYTES = 8 * HTB, NXCD = 8, WGM = 8;

__host__ __device__ __forceinline__ int lds_byte(int r, int c) { const int st = (r >> 4) * 2 + (c >> 5), rr = r & 15, cc = c & 31, ob = rr * 64 + cc * 2; return st * 1024 + (ob ^ (((ob >> 9) & 1) << 5)); }
__host__ __device__ __forceinline__ void stage_rc(int b, int& R, int& C) { const int st = b / 1024, sb = b % 1024, swz = sb ^ (((sb >> 9) & 1) << 5); R = (st >> 1) * 16 + swz / 64; C = (st & 1) * 32 + (swz % 64) / 2; }
__host__ __device__ __forceinline__ int perm32(int rho) { const int n = rho >> 4, i = rho & 15; return 8 * (i >> 2) + 4 * n + (i & 3); }

struct Unit { int pm, pn; };
struct Gemm { const bf16_t* A; const bf16_t* Bt; int M, N, K; };

struct StaticOrder {
    int nM, nN, nwg, G, c;
    __host__ __device__ void init(int M, int N, int G_, int c_) { nM = M / BM; nN = N / BM; nwg = nM * nN; G = G_; c = c_; }
    __host__ __device__ bool next(int i, Unit& u) const {
        const long L = (long)i * G + c; if (L >= nwg) return false;
        int wgid = (int)L; { const int q = nwg / NXCD, r = nwg % NXCD, xcd = wgid % NXCD, off = wgid / NXCD; wgid = (xcd < r ? xcd * (q + 1) : r * (q + 1) + (xcd - r) * q) + off; }
        const int nig = WGM * nN, gid = wgid / nig, fm = gid * WGM, gsz = (nM - fm) < WGM ? (nM - fm) : WGM;
        u.pm = fm + ((wgid % nig) % gsz); u.pn = (wgid % nig) / gsz; return true;
    }
    __device__ __forceinline__ void a_ready(const Unit&) const {}
    __device__ __forceinline__ void done(const Unit&) const {}
};

__device__ __forceinline__ unsigned cvt_pk_bf16(float lo, float hi) { unsigned r; asm volatile("v_cvt_pk_bf16_f32 %0, %1, %2" : "=v"(r) : "v"(lo), "v"(hi)); return r; }
typedef float f32x2 __attribute__((ext_vector_type(2)));
__device__ __forceinline__ f32x2 gelu_pk(f32x2 v) {
    const f32x2 av = __builtin_elementwise_abs(v), d = av * 0.2316418882f + 1.0f;
    f32x2 t; t.x = __builtin_amdgcn_rcpf(d.x); t.y = __builtin_amdgcn_rcpf(d.y);
    f32x2 q = t * 0.5307027145f + (-0.7265760135f); q = q * t + 0.7107068705f; q = q * t + (-0.142248368f); q = q * t + 0.127414796f; q = q * t;
    const f32x2 s = (v * v) * (-0.72134752044f);
    f32x2 e; e.x = __builtin_amdgcn_exp2f(s.x); e.y = __builtin_amdgcn_exp2f(s.y);
    const f32x2 m = v * (q * e), r = v - m;
    f32x2 o; o.x = v.x < 0.f ? m.x : r.x; o.y = v.y < 0.f ? m.y : r.y; return o;
}
__device__ __forceinline__ float sigm(float x) { return __builtin_amdgcn_rcpf(1.0f + __expf(-x)); }
__device__ __forceinline__ float bf2f(unsigned short u) { return __uint_as_float((unsigned)u << 16); }


struct EpiProj {
    static constexpr bool PERM = true, AFTER_DRAIN = false; static constexpr int MID_T = 0;
    unsigned char* ws;
    __device__ __forceinline__ void mid(f32x4 (&acc)[2][2][4][2], const Unit& u, int wr, int wc, int fr, int fq) const {}
    __device__ __forceinline__ void operator()(const f32x4 (&acc)[2][2][4][2], const Unit& u, int wr, int wc, int fr, int fq) const {
        const int row0 = u.pm * BM + wr * 64 + fr; const int pn = u.pn; const float* rstd = (const float*)(ws + WS_RSTD);
        bf16_t* base; int ld, colt; bool act = false;
        if (pn < 12) { base = (bf16_t*)(ws + WS_A); ld = 3072; colt = pn * BM; }
        else if (pn < 16) { base = (bf16_t*)(ws + WS_C); ld = 1024; colt = (pn - 12) * BM; }
        else if (pn < 24) { base = (bf16_t*)(ws + WS_D); ld = 2048; colt = (pn - 16) * BM; act = true; }
        else { base = (bf16_t*)(ws + WS_E); ld = 2048; colt = (pn - 24) * BM; }
        const int col0 = colt + wc * 32 + 8 * fq;
#pragma unroll
        for (int ai = 0; ai < 2; ++ai)
#pragma unroll
            for (int m = 0; m < 4; ++m) { const int row = row0 + ai * HALF + m * 16; const float rs = rstd[row]; bf16_t* rowp = base + (size_t)row * ld + col0;
#pragma unroll
                for (int bj = 0; bj < 2; ++bj) { f32x4 v0 = acc[ai][bj][m][0] * rs, v1 = acc[ai][bj][m][1] * rs;
                    if (act) { f32x2 a = gelu_pk((f32x2){v0[0], v0[1]}), b = gelu_pk((f32x2){v0[2], v0[3]}), c = gelu_pk((f32x2){v1[0], v1[1]}), d = gelu_pk((f32x2){v1[2], v1[3]});
                        v0 = (f32x4){a.x, a.y, b.x, b.y}; v1 = (f32x4){c.x, c.y, d.x, d.y}; }
                    u32x4 w; w.x = cvt_pk_bf16(v0[0], v0[1]); w.y = cvt_pk_bf16(v0[2], v0[3]); w.z = cvt_pk_bf16(v1[0], v1[1]); w.w = cvt_pk_bf16(v1[2], v1[3]);
                    *(u32x4*)(rowp + bj * HALF) = w; } }
    }
};
struct EpiMerge {
    static constexpr bool PERM = true, AFTER_DRAIN = false; static constexpr int MID_T = 16;
    unsigned char* ws;
    __device__ __forceinline__ void mid(f32x4 (&acc)[2][2][4][2], const Unit& u, int wr, int wc, int fr, int fq) const {
        int row0 = u.pm * BM + wr * 64 + fr, col0 = u.pn * BM + wc * 32 + 8 * fq;
        asm volatile("" : "+v"(row0), "+v"(col0));
        const bf16_t* GT = (const bf16_t*)(ws + WS_E);
#pragma unroll
        for (int ai = 0; ai < 2; ++ai)
#pragma unroll
            for (int m = 0; m < 4; ++m) { const bf16_t* gp = GT + (size_t)(row0 + ai * HALF + m * 16) * 2048 + col0;
#pragma unroll
                for (int bj = 0; bj < 2; ++bj) { const u32x4 ga = *(const u32x4*)(gp + bj * HALF), gb = *(const u32x4*)(gp + 1024 + bj * HALF);
#pragma unroll
                    for (int n = 0; n < 2; ++n)
#pragma unroll
                        for (int e = 0; e < 4; ++e) { const unsigned wa = ga[n * 2 + (e >> 1)], wb = gb[n * 2 + (e >> 1)];
                            const float a = (e & 1) ? __uint_as_float(wa & 0xffff0000u) : __uint_as_float(wa << 16), b = (e & 1) ? __uint_as_float(wb & 0xffff0000u) : __uint_as_float(wb << 16);
                            acc[ai][bj][m][n][e] *= (1.0f + __expf(-b)) * __builtin_amdgcn_rcpf(1.0f + __expf(-a)); }
                    asm volatile("" ::: "memory"); } }
    }
    __device__ __forceinline__ void operator()(const f32x4 (&acc)[2][2][4][2], const Unit& u, int wr, int wc, int fr, int fq) const {
        const int row0 = u.pm * BM + wr * 64 + fr, col0 = u.pn * BM + wc * 32 + 8 * fq; const bf16_t* GT = (const bf16_t*)(ws + WS_E); bf16_t* O = (bf16_t*)(ws + WS_C);
#pragma unroll
        for (int ai = 0; ai < 2; ++ai)
#pragma unroll
            for (int m = 0; m < 4; ++m) { const int row = row0 + ai * HALF + m * 16; const bf16_t* gp = GT + (size_t)row * 2048 + 1024 + col0; bf16_t* rowp = O + (size_t)row * 1024 + col0;
#pragma unroll
                for (int bj = 0; bj < 2; ++bj) { const u32x4 gb = *(const u32x4*)(gp + bj * HALF); float o[8];
#pragma unroll
                    for (int n = 0; n < 2; ++n)
#pragma unroll
                        for (int e = 0; e < 4; ++e) { const unsigned wb = gb[n * 2 + (e >> 1)]; const float b = (e & 1) ? __uint_as_float(wb & 0xffff0000u) : __uint_as_float(wb << 16);
                            o[n * 4 + e] = acc[ai][bj][m][n][e] * sigm(b); }
                    u32x4 w; w.x = cvt_pk_bf16(o[0], o[1]); w.y = cvt_pk_bf16(o[2], o[3]); w.z = cvt_pk_bf16(o[4], o[5]); w.w = cvt_pk_bf16(o[6], o[7]);
                    *(u32x4*)(rowp + bj * HALF) = w; } }
    }
};
struct EpiF32 {
    static constexpr bool PERM = true, AFTER_DRAIN = false; static constexpr int MID_T = 0;
    unsigned char* ws;
    __device__ __forceinline__ void mid(f32x4 (&acc)[2][2][4][2], const Unit& u, int wr, int wc, int fr, int fq) const {}
    __device__ __forceinline__ void operator()(const f32x4 (&acc)[2][2][4][2], const Unit& u, int wr, int wc, int fr, int fq) const {
        const int row0 = u.pm * BM + wr * 64 + fr, col0 = u.pn * BM + wc * 32 + 8 * fq; float* Y = (float*)(ws + WS_D); constexpr int ldc = DM;
#pragma unroll
        for (int ai = 0; ai < 2; ++ai)
#pragma unroll
            for (int m = 0; m < 4; ++m) { float* rowp = Y + (size_t)(row0 + ai * HALF + m * 16) * ldc + col0;
#pragma unroll
                for (int bj = 0; bj < 2; ++bj) { *(f32x4*)(rowp + bj * HALF) = acc[ai][bj][m][0]; *(f32x4*)(rowp + bj * HALF + 4) = acc[ai][bj][m][1]; } }
    }
};
struct EpiSwiglu {
    static constexpr bool PERM = true, AFTER_DRAIN = false; static constexpr int MID_T = 0;
    unsigned char* ws;
    __device__ __forceinline__ void mid(f32x4 (&acc)[2][2][4][2], const Unit& u, int wr, int wc, int fr, int fq) const {}
    __device__ __forceinline__ void operator()(const f32x4 (&acc)[2][2][4][2], const Unit& u, int wr, int wc, int fr, int fq) const {
        const int row0 = u.pm * BM + wr * 64 + fr, col0 = u.pn * HALF + wc * 32 + 8 * fq; bf16_t* Hh = (bf16_t*)(ws + WS_A); constexpr int ldh = DFF; const float* rstd = (const float*)(ws + WS_RSTD);
#pragma unroll
        for (int ai = 0; ai < 2; ++ai)
#pragma unroll
            for (int m = 0; m < 4; ++m) { const int row = row0 + ai * HALF + m * 16; const float rs = rstd[row]; float o[8];
#pragma unroll
                for (int n = 0; n < 2; ++n)
#pragma unroll
                    for (int e = 0; e < 4; ++e) { const float g = acc[ai][0][m][n][e] * rs, up = acc[ai][1][m][n][e] * rs; o[n * 4 + e] = g * sigm(g) * up; }
                u32x4 w; w.x = cvt_pk_bf16(o[0], o[1]); w.y = cvt_pk_bf16(o[2], o[3]); w.z = cvt_pk_bf16(o[4], o[5]); w.w = cvt_pk_bf16(o[6], o[7]);
                *(u32x4*)(Hh + (size_t)row * ldh + col0) = w; }
    }
};

struct EpiAny {
    static constexpr bool PERM = true, AFTER_DRAIN = false; static constexpr int MID_T = 1;
    int kind, mid_t;
    unsigned char* ws;
    __device__ __forceinline__ void mid(f32x4 (&acc)[2][2][4][2], const Unit& u, int wr, int wc, int fr, int fq) const { EpiMerge{ws}.mid(acc, u, wr, wc, fr, fq); }
    __device__ __forceinline__ void operator()(const f32x4 (&acc)[2][2][4][2], const Unit& u, int wr, int wc, int fr, int fq) const {
        if (kind == 0) EpiProj{ws}(acc, u, wr, wc, fr, fq); else if (kind == 1) EpiMerge{ws}(acc, u, wr, wc, fr, fq); else if (kind == 2) EpiF32{ws}(acc, u, wr, wc, fr, fq); else EpiSwiglu{ws}(acc, u, wr, wc, fr, fq);
    }
};

template <class Epi, class Sched, bool ALIGN_EPI = false, bool SP2 = false>
__device__ __forceinline__ void gemm_phase(PG8_LAS unsigned char* lds, const Gemm g, const Sched& S, const Epi& E) {
    int tid_ = threadIdx.x; asm volatile("" : "+v"(tid_));
    const int tid = tid_, wid = __builtin_amdgcn_readfirstlane(tid >> 6), lane = tid & 63, wr = wid >> 2, wc = wid & 3, fr = lane & 15, fq = lane >> 4;
    const int K = g.K, nt = K / BK;
    unsigned voffA[2], voffB[2];
#pragma unroll
    for (int i = 0; i < 2; ++i) { int R, C; stage_rc(tid * 16 + i * 8192, R, C); const int Rb = Epi::PERM ? ((R & ~31) + perm32(R & 31)) : R;
        voffA[i] = (unsigned)(R * K + C) * 2u; voffB[i] = (unsigned)(Rb * K + C) * 2u; }
    const size_t kstep = (size_t)(BK * 2);
    const size_t hstep = (size_t)HALF * K * 2;
    const size_t tstep = 2 * hstep;
    const unsigned ldsw = (unsigned)wid * 1024u;
    const int aoff = lds_byte(wr * 64 + fr, fq * 8), boff = lds_byte(wc * 32 + fr, fq * 8);
#define PG8_SA(b, h) (((b) * 2 + (h)) * HTB)
#define PG8_SB(b, h) ((4 + (b) * 2 + (h)) * HTB)
#define PG8_STAGE(bufoff, gbase, voff) do { _Pragma("unroll") for (int _i = 0; _i < 2; ++_i) \
        __builtin_amdgcn_global_load_lds((const unsigned*)((const char*)(gbase) + (voff)[_i]), (PG8_LAS unsigned*)(lds + (bufoff) + ldsw + _i * 8192), 16, 0, 0); } while (0)
#define PG8_LDA(dst, b, h) do { _Pragma("unroll") for (int m = 0; m < 4; ++m) _Pragma("unroll") for (int k = 0; k < 2; ++k) dst[m][k] = *(const PG8_LAS bf16x8*)(lds + PG8_SA(b, h) + aoff + m * 2048 + k * 1024); } while (0)
#define PG8_LDB(dst, b, h) do { _Pragma("unroll") for (int n = 0; n < 2; ++n) _Pragma("unroll") for (int k = 0; k < 2; ++k) dst[n][k] = *(const PG8_LAS bf16x8*)(lds + PG8_SB(b, h) + boff + n * 2048 + k * 1024); } while (0)
#define PG8_MMA(ai, bj, At, Bt) do { __builtin_amdgcn_s_setprio(1); _Pragma("unroll") for (int m = 0; m < 4; ++m) _Pragma("unroll") for (int n = 0; n < 2; ++n) _Pragma("unroll") for (int k = 0; k < 2; ++k) \
        acc[ai][bj][m][n] = __builtin_amdgcn_mfma_f32_16x16x32_bf16(Bt[n][k], At[m][k], acc[ai][bj][m][n], 0, 0, 0); __builtin_amdgcn_s_setprio(0); } while (0)
#define PG8_WAIT_V(n) asm volatile("s_waitcnt vmcnt(" #n ")" ::: "memory")
#define PG8_WAIT_L(n) asm volatile("s_waitcnt lgkmcnt(" #n ")" ::: "memory")
#define PG8_BAR __builtin_amdgcn_s_barrier()
#define PG8_SCHED __builtin_amdgcn_sched_barrier(0)
    Unit cur, nxt; int ui = 0;
    if (!S.next(0, cur)) return;
    f32x4 acc[2][2][4][2];
#pragma unroll
    for (int a = 0; a < 2; ++a)
#pragma unroll
        for (int b = 0; b < 2; ++b)
#pragma unroll
            for (int m = 0; m < 4; ++m)
#pragma unroll
                for (int n = 0; n < 2; ++n) acc[a][b][m][n] = (f32x4){0.f, 0.f, 0.f, 0.f};
    bf16x8 At[4][2], B0[2][2], B1[2][2];
    const char* cA = (const char*)g.A + (size_t)cur.pm * tstep; const char* cB = (const char*)g.Bt + (size_t)cur.pn * tstep;
    S.a_ready(cur);
    if constexpr (SP2) {
        PG8_STAGE(PG8_SB(0, 0), cB, voffB); PG8_STAGE(PG8_SB(0, 1), cB + hstep, voffB); PG8_STAGE(PG8_SA(0, 0), cA, voffA); PG8_STAGE(PG8_SA(0, 1), cA + hstep, voffA);
        if (wr == 1) PG8_BAR;
        PG8_WAIT_V(2); PG8_BAR;
        PG8_STAGE(PG8_SB(1, 0), cB + kstep, voffB); PG8_STAGE(PG8_SA(1, 0), cA + kstep, voffA); PG8_STAGE(PG8_SB(1, 1), cB + hstep + kstep, voffB);
        PG8_WAIT_V(6); PG8_BAR;
    } else {
        PG8_STAGE(PG8_SB(0, 0), cB, voffB); PG8_STAGE(PG8_SA(0, 0), cA, voffA); PG8_STAGE(PG8_SB(0, 1), cB + hstep, voffB); PG8_STAGE(PG8_SA(0, 1), cA + hstep, voffA);
        if (wr == 1) PG8_BAR;
        PG8_WAIT_V(4); PG8_BAR;
        PG8_STAGE(PG8_SB(1, 0), cB + kstep, voffB); PG8_STAGE(PG8_SA(1, 0), cA + kstep, voffA); PG8_STAGE(PG8_SB(1, 1), cB + hstep + kstep, voffB);
        PG8_WAIT_V(6); PG8_BAR;
    }
    for (;;) {
        const bool has_next = S.next(ui + 1, nxt);
        const char* nA = has_next ? (const char*)g.A + (size_t)nxt.pm * tstep : cA; const char* nB = has_next ? (const char*)g.Bt + (size_t)nxt.pn * tstep : cB;
        for (int t = 0; t < nt; t += 2) {
            const bool last = (t == nt - 2);
            const char* a1 = cA + (size_t)(t + 1) * kstep;
            const char* a2 = last ? nA : cA + (size_t)(t + 2) * kstep; const char* b2 = last ? nB : cB + (size_t)(t + 2) * kstep;
            const char* a3 = a2 + kstep; const char* b3 = b2 + kstep;
            if (last && has_next) S.a_ready(nxt);
            if constexpr (Epi::MID_T > 0) { if (t == E.mid_t) E.mid(acc, cur, wr, wc, fr, fq); }
            if constexpr (SP2) {
            PG8_LDB(B0, 0, 0); PG8_LDB(B1, 0, 1); PG8_SCHED; PG8_LDA(At, 0, 0); PG8_STAGE(PG8_SA(1, 1), a1 + hstep, voffA);
            PG8_WAIT_V(8); PG8_WAIT_L(0); PG8_BAR; PG8_MMA(0, 0, At, B0); PG8_MMA(0, 1, At, B1); PG8_BAR; PG8_SCHED;
            PG8_LDA(At, 0, 1); PG8_STAGE(PG8_SB(0, 0), b2, voffB); PG8_STAGE(PG8_SB(0, 1), b2 + hstep, voffB); PG8_STAGE(PG8_SA(0, 0), a2, voffA);
            PG8_WAIT_V(8); PG8_WAIT_L(0); PG8_BAR; PG8_MMA(1, 0, At, B0); PG8_MMA(1, 1, At, B1); PG8_BAR; PG8_SCHED;
            PG8_LDB(B0, 1, 0); PG8_LDB(B1, 1, 1); PG8_SCHED; PG8_LDA(At, 1, 0); PG8_STAGE(PG8_SA(0, 1), a2 + hstep, voffA);
            PG8_WAIT_V(8); PG8_WAIT_L(0); PG8_BAR; PG8_MMA(0, 0, At, B0); PG8_MMA(0, 1, At, B1); PG8_BAR; PG8_SCHED;
            PG8_LDA(At, 1, 1); PG8_STAGE(PG8_SB(1, 0), b3, voffB); PG8_STAGE(PG8_SB(1, 1), b3 + hstep, voffB); PG8_STAGE(PG8_SA(1, 0), a3, voffA);
            PG8_WAIT_V(8); PG8_WAIT_L(0); PG8_BAR; PG8_MMA(1, 0, At, B0); PG8_MMA(1, 1, At, B1); PG8_BAR; PG8_SCHED;
            } else {
            PG8_LDB(B0, 0, 0); PG8_SCHED; PG8_LDA(At, 0, 0); PG8_STAGE(PG8_SA(1, 1), a1 + hstep, voffA);
            PG8_WAIT_L(8); PG8_BAR; PG8_WAIT_L(0); PG8_MMA(0, 0, At, B0); PG8_BAR; PG8_SCHED;
            PG8_LDB(B1, 0, 1); PG8_STAGE(PG8_SB(0, 0), b2, voffB);
            PG8_BAR; PG8_WAIT_L(0); PG8_MMA(0, 1, At, B1); PG8_BAR;
            PG8_LDA(At, 0, 1); PG8_STAGE(PG8_SA(0, 0), a2, voffA);
            PG8_BAR; PG8_WAIT_L(0); PG8_MMA(1, 0, At, B0); PG8_BAR; PG8_SCHED;
            PG8_STAGE(PG8_SB(0, 1), b2 + hstep, voffB);
            PG8_WAIT_V(6); PG8_BAR; PG8_MMA(1, 1, At, B1); PG8_BAR;
            PG8_LDB(B0, 1, 0); PG8_SCHED; PG8_LDA(At, 1, 0); PG8_STAGE(PG8_SA(0, 1), a2 + hstep, voffA);
            PG8_WAIT_L(8); PG8_BAR; PG8_WAIT_L(0); PG8_MMA(0, 0, At, B0); PG8_BAR; PG8_SCHED;
            PG8_LDB(B1, 1, 1); PG8_STAGE(PG8_SB(1, 0), b3, voffB);
            PG8_BAR; PG8_WAIT_L(0); PG8_MMA(0, 1, At, B1); PG8_BAR;
            PG8_LDA(At, 1, 1); PG8_STAGE(PG8_SA(1, 0), a3, voffA);
            PG8_BAR; PG8_WAIT_L(0); PG8_MMA(1, 0, At, B0); PG8_BAR; PG8_SCHED;
            PG8_STAGE(PG8_SB(1, 1), b3 + hstep, voffB);
            PG8_WAIT_V(6); PG8_BAR; PG8_MMA(1, 1, At, B1); PG8_BAR;
            }
        }
        if constexpr (ALIGN_EPI) { if (wr == 0) PG8_BAR; }
        if constexpr (!Epi::AFTER_DRAIN) { E(acc, cur, wr, wc, fr, fq); S.done(cur); }
        if (!has_next) break;
#pragma unroll
        for (int a = 0; a < 2; ++a)
#pragma unroll
            for (int b = 0; b < 2; ++b)
#pragma unroll
                for (int m = 0; m < 4; ++m)
#pragma unroll
                    for (int n = 0; n < 2; ++n) acc[a][b][m][n] = (f32x4){0.f, 0.f, 0.f, 0.f};
        cur = nxt; cA = nA; cB = nB; ++ui;
        if constexpr (ALIGN_EPI) { if (wr == 1) PG8_BAR; }
    }
    PG8_WAIT_V(0);
    if constexpr (!ALIGN_EPI) { if (wr == 0) PG8_BAR; }
    PG8_BAR;
#undef PG8_SA
#undef PG8_SB
#undef PG8_STAGE
#undef PG8_LDA
#undef PG8_LDB
#undef PG8_MMA
#undef PG8_WAIT_V
#undef PG8_WAIT_L
#undef PG8_BAR
#undef PG8_SCHED
}
}


#define LAS __attribute__((address_space(3)))
#define DI __device__ __forceinline__
typedef unsigned short bf16;
typedef unsigned v4u __attribute__((ext_vector_type(4)));
typedef unsigned v2u __attribute__((ext_vector_type(2)));
typedef float f32x4 __attribute__((ext_vector_type(4)));
#define LDS_WAIT() asm volatile("s_waitcnt lgkmcnt(0)" ::: "memory")

DI unsigned f2bf(float f) { unsigned u = __builtin_bit_cast(unsigned, f); return (u + 0x7fffu + ((u >> 16) & 1u)) >> 16; }
DI unsigned pk2(float lo, float hi) { return f2bf(lo) | (f2bf(hi) << 16); }
DI float bflo(unsigned w) { return __uint_as_float(w << 16); }
DI float bfhi(unsigned w) { return __uint_as_float(w & 0xffff0000u); }
DI float wave_sum(float v) {
#pragma unroll
    for (int o = 1; o < 64; o <<= 1) v += __shfl_xor(v, o);
    return v;
}
DI float sigmoidf_(float x) { return __builtin_amdgcn_rcpf(1.0f + __expf(-x)); }
DI float siluf_(float x) { return x * __builtin_amdgcn_rcpf(1.0f + __expf(-x)); }
DI float rsq_(float x) { return __builtin_amdgcn_rsqf(x); }
DI float softplus_(float x) { const float y = __expf(x); return (y < 0.03f) ? y * (1.0f - y * (0.5f - y * (0.33333333f - 0.25f * y))) : __logf(1.0f + y); }

struct Args { const float* in[22]; float* out; unsigned char* ws; int ph_lo, ph_hi; };
struct KIn {
    DI const float* operator[](int k) const { auto kp = __builtin_amdgcn_kernarg_segment_ptr(); asm volatile("" : "+s"(kp));
        return ((const float* const __attribute__((address_space(4)))*)kp)[k]; }
};
struct Frame { LAS unsigned char* lds; int tid, lane, wave, G, bid; KIn in; float* out; unsigned char* ws; };

DI void tr_item(const float* W, int ldsrc, int k0, int c0, const float* scale, bf16* WT, int ldk, int n0, int koff, LAS float* scr, int lane) {
#pragma unroll 8
    for (int i = 0; i < 32; ++i) { const int kk = 2 * i + (lane >> 5); float w = W[(size_t)(k0 + kk) * ldsrc + c0 + (lane & 31)]; if (scale) w *= scale[k0 + kk]; scr[kk * 33 + (lane & 31)] = w; }
    LDS_WAIT(); asm volatile("" ::: "memory");
    const int c = lane & 7;
#pragma unroll
    for (int j = 0; j < 4; ++j) { const int n = (lane >> 3) + 8 * j; const LAS float* s = scr + (8 * c) * 33 + n;
        v4u o; o.x = pk2(s[0 * 33], s[1 * 33]); o.y = pk2(s[2 * 33], s[3 * 33]); o.z = pk2(s[4 * 33], s[5 * 33]); o.w = pk2(s[6 * 33], s[7 * 33]);
        *(v4u*)(WT + (size_t)(n0 + n) * ldk + koff + k0 + 8 * c) = o; }
    LDS_WAIT(); asm volatile("" ::: "memory");
}
DI void p0_weights(Frame& F) {
    LAS float* scr = (LAS float*)(F.lds + F.wave * 16384);
    const int gw = F.bid * NWAVES + F.wave, NGW = F.G * NWAVES;
    constexpr int I_IN = 16 * 256, I_P = 16 * 32, I_FI = 16 * 176, I_FO = 44 * 32, I_L = I_IN + 3 * I_P + I_FI + I_FO;
    for (int it = gw; it < DEPTH * I_L; it += NGW) {
        const int l = it / I_L; int r = it % I_L; unsigned char* wl = F.ws + WS_W + (size_t)l * W_LAYER;
        if (r < I_IN) { const int kb = r / 256, nb = r % 256, n0 = 32 * nb, c0 = n0 + (n0 >= 4096 ? 16 : 0);
            tr_item(F.in[5] + (size_t)l * DM * DIN, DIN, 64 * kb, c0, F.in[4] + l * DM, (bf16*)(wl + W_IN), DM, n0, 0, scr, F.lane); continue; } r -= I_IN;
        if (r < I_P) { const int kb = r / 32, nb = r % 32; tr_item(F.in[14] + (size_t)l * DM * DM, DM, 64 * kb, 32 * nb, nullptr, (bf16*)(wl + W_PAB), 2048, 32 * nb, 0, scr, F.lane); continue; } r -= I_P;
        if (r < I_P) { const int kb = r / 32, nb = r % 32; tr_item(F.in[15] + (size_t)l * DM * DM, DM, 64 * kb, 32 * nb, nullptr, (bf16*)(wl + W_PAB), 2048, 32 * nb, 1024, scr, F.lane); continue; } r -= I_P;
        if (r < I_P) { const int kb = r / 32, nb = r % 32; tr_item(F.in[16] + (size_t)l * DM * DM, DM, 64 * kb, 32 * nb, nullptr, (bf16*)(wl + W_OUT), DM, 32 * nb, 0, scr, F.lane); continue; } r -= I_P;
        if (r < I_FI) { const int kb = r / 176, nb = r % 176, n0 = 32 * nb, p = n0 / 256, j = n0 % 256, c0 = (j < 128) ? 128 * p + j : DFF + 128 * p + (j - 128);
            tr_item(F.in[19] + (size_t)l * DM * 2 * DFF, 2 * DFF, 64 * kb, c0, F.in[18] + l * DM, (bf16*)(wl + W_FIN), DM, n0, 0, scr, F.lane); continue; } r -= I_FI;
        { const int kb = r / 32, nb = r % 32; tr_item(F.in[20] + (size_t)l * DFF * DM, DM, 64 * kb, 32 * nb, nullptr, (bf16*)(wl + W_FOUT), DFF, 32 * nb, 0, scr, F.lane); }
    }
}

DI void load_wab_lds(Frame& F, int lab) {
    __syncthreads();
    LAS float* wab = (LAS float*)F.lds;
    for (int i = F.tid; i < 16 * DM; i += NWAVES * 64) { const int c = i & 15, k = i >> 4;
        wab[c * DM + k] = F.in[5][(size_t)lab * DM * DIN + (size_t)k * DIN + 4096 + c] * F.in[4][lab * DM + k]; }
    __syncthreads();
}
DI void rowprep(Frame& F, const f32x4 (&v)[4], int row, int lab) {
    float s = 0.f;
#pragma unroll
    for (int j = 0; j < 4; ++j) s += (v[j].x * v[j].x + v[j].y * v[j].y) + (v[j].z * v[j].z + v[j].w * v[j].w);
    const float rstd = rsq_(wave_sum(s) * (1.0f / DM) + 1e-6f);
    if (F.lane == 0) ((float*)(F.ws + WS_RSTD))[row] = rstd;
    v2u* xb = (v2u*)((bf16*)(F.ws + WS_XB) + (size_t)row * DM) + F.lane;
#pragma unroll
    for (int j = 0; j < 4; ++j) { v2u o; o.x = pk2(v[j].x, v[j].y); o.y = pk2(v[j].z, v[j].w); xb[64 * j] = o; }
    if (lab >= 0) {
        const LAS f32x4* wab = (const LAS f32x4*)F.lds;
        float mine = 0.f;
#pragma unroll 4
        for (int c = 0; c < 16; ++c) {
            float p = 0.f;
#pragma unroll
            for (int j = 0; j < 4; ++j) { const f32x4 w = wab[c * (DM / 4) + F.lane + 64 * j]; p += (v[j].x * w.x + v[j].y * w.y) + (v[j].z * w.z + v[j].w * w.w); }
            p = wave_sum(p);
            if (F.lane == c) mine = p;
        }
        if (F.lane < 16) {
            const float a = mine * rstd; float r;
            if (F.lane < 8) { const float x = a + F.in[8][lab * NH + F.lane]; const float sp = (x > 20.f) ? x : softplus_(x); r = -__expf(F.in[7][lab * NH + F.lane]) * sp; }
            else r = sigmoidf_(a);
            ((float*)(F.ws + WS_AB))[(size_t)row * 16 + F.lane] = r;
        }
    }
}
DI void p0_rows(Frame& F) {
    load_wab_lds(F, 0);
    const int gw = F.bid * NWAVES + F.wave, NGW = F.G * NWAVES;
    for (int row = gw; row < TT; row += NGW) {
        const float* xr = (row < TP) ? F.in[0] + (size_t)row * DM : F.in[1] + (size_t)(row - TP) * DM;
        f32x4 v[4];
#pragma unroll
        for (int j = 0; j < 4; ++j) v[j] = ((const f32x4*)xr)[F.lane + 64 * j];
        rowprep(F, v, row, 0);
    }
}
DI void rows_residual(Frame& F, const float* Y, const float* w, bool x_from_in, bool fin, int lab) {
    if (!fin && lab >= 0) load_wab_lds(F, lab);
    const int gw = F.bid * NWAVES + F.wave, NGW = F.G * NWAVES;
    for (int row = gw; row < TT; row += NGW) {
        const float* xr = x_from_in ? ((row < TP) ? F.in[0] + (size_t)row * DM : F.in[1] + (size_t)(row - TP) * DM) : F.out + (size_t)row * DM;
        f32x4 y[4], x[4]; float s = 0.f;
#pragma unroll
        for (int j = 0; j < 4; ++j) { y[j] = ((const f32x4*)(Y + (size_t)row * DM))[F.lane + 64 * j]; x[j] = ((const f32x4*)xr)[F.lane + 64 * j];
            s += (y[j].x * y[j].x + y[j].y * y[j].y) + (y[j].z * y[j].z + y[j].w * y[j].w); }
        const float ry = rsq_(wave_sum(s) * (1.0f / DM) + 1e-6f);
#pragma unroll
        for (int j = 0; j < 4; ++j) { const f32x4 ww = ((const f32x4*)w)[F.lane + 64 * j]; x[j] = x[j] + y[j] * ry * ww; ((f32x4*)(F.out + (size_t)row * DM))[F.lane + 64 * j] = x[j]; }
        if (!fin) rowprep(F, x, row, lab);
    }
}

DI void e1_conv(Frame& F, int l) {
    const int gw = F.bid * NWAVES + F.wave, NGW = F.G * NWAVES;
    const bf16* raw = (const bf16*)(F.ws + WS_A); bf16* qc = (bf16*)(F.ws + WS_B);
    const float* cw = F.in[6] + (size_t)l * 4 * DCONV;
    for (int row = gw; row < TT; row += NGW) {
        const bool smp = row >= TP; const int seq = smp ? (row - TP) / TS_ : row / SEQ, t = smp ? (row - TP) % TS_ : row % SEQ, L = smp ? TS_ : SEQ;
        const float* sc = F.in[3] + ((size_t)l * NS + seq) * 3 * DCONV;
        float* sco = smp ? F.out + O_SCS + ((size_t)l * NS + seq) * 3 * DCONV : F.out + O_SCP + ((size_t)l * NB + seq) * 3 * DCONV;
        for (int seg = 0; seg < 24; ++seg) {
            const int ch = seg * 128 + 2 * F.lane; float a0 = 0.f, a1 = 0.f, x0 = 0.f, x1 = 0.f;
#pragma unroll
            for (int i = 0; i < 4; ++i) { const int tt = t - 3 + i;
                if (tt >= 0) { const unsigned w = *(const unsigned*)(raw + (size_t)(row - 3 + i) * DCONV + ch); x0 = bflo(w); x1 = bfhi(w); }
                else if (smp) { x0 = sc[(size_t)(t + i) * DCONV + ch]; x1 = sc[(size_t)(t + i) * DCONV + ch + 1]; }
                else { x0 = 0.f; x1 = 0.f; }
                a0 += cw[i * DCONV + ch] * x0; a1 += cw[i * DCONV + ch + 1] * x1; }
            if (t >= L - 3) { sco[(size_t)(t - (L - 3)) * DCONV + ch] = x0; sco[(size_t)(t - (L - 3)) * DCONV + ch + 1] = x1; }
            a0 = siluf_(a0); a1 = siluf_(a1);
            if (seg < 16) { const float ss = wave_sum(a0 * a0 + a1 * a1); const float scl = rsq_(ss + 1e-6f) * (seg < 8 ? 0.08838834764831845f : 1.0f); a0 *= scl; a1 *= scl; }
            *(unsigned*)(qc + (size_t)row * DCONV + ch) = pk2(a0, a1);
        }
    }
}
DI void e2_ln_row(Frame& F, int l, int row) {
    const bf16* uv = (const bf16*)(F.ws + WS_D); bf16* vn = (bf16*)(F.ws + WS_A + 68 * MiB);
    const float* lw = F.in[10] + l * DB; const float* lb = F.in[11] + l * DB;
    f32x4 v[4]; float s = 0.f;
#pragma unroll
    for (int j = 0; j < 4; ++j) { const v2u w = *((const v2u*)(uv + (size_t)row * 2048 + 1024) + F.lane + 64 * j); v[j] = (f32x4){bflo(w.x), bfhi(w.x), bflo(w.y), bfhi(w.y)}; s += (v[j].x + v[j].y) + (v[j].z + v[j].w); }
    const float mean = wave_sum(s) * (1.0f / DB); float q = 0.f;
#pragma unroll
    for (int j = 0; j < 4; ++j) { v[j] = v[j] - mean; q += (v[j].x * v[j].x + v[j].y * v[j].y) + (v[j].z * v[j].z + v[j].w * v[j].w); }
    const float rstd = rsq_(wave_sum(q) * (1.0f / DB) + 1e-5f);
    const bool smp = row >= TP; const int seq = smp ? (row - TP) / TS_ : row / SEQ, t = smp ? (row - TP) % TS_ : row % SEQ;
    float* cvo = nullptr;
    if (smp) cvo = F.out + O_CVS + (((size_t)l * NS + seq) * TS_ + t) * DB; else if (t >= SEQ - 128) cvo = F.out + O_CVP + (((size_t)l * NB + seq) * 128 + (t - (SEQ - 128))) * DB;
#pragma unroll
    for (int j = 0; j < 4; ++j) { const f32x4 ww = ((const f32x4*)lw)[F.lane + 64 * j], bb = ((const f32x4*)lb)[F.lane + 64 * j]; const f32x4 o = v[j] * rstd * ww + bb;
        v2u pk; pk.x = pk2(o.x, o.y); pk.y = pk2(o.z, o.w); *((v2u*)(vn + (size_t)row * DB) + F.lane + 64 * j) = pk;
        if (cvo) ((f32x4*)cvo)[F.lane + 64 * j] = o; }
}
DI void d_unit(Frame& F, int l, bool smp, int seq, int h, int half) {
    const bf16* qc = (const bf16*)(F.ws + WS_B); const float* ab = (const float*)(F.ws + WS_AB); float* oraw = (float*)(F.ws + WS_A);
    const int T = smp ? TS_ : SEQ, row0 = smp ? TP + seq * TS_ : seq * SEQ, dv = half * 64 + F.lane;
    float S[128];
    if (smp) { const float* s0 = F.in[2] + (((size_t)l * NS + seq) * NH + h) * HD * HD + dv;
#pragma unroll
        for (int k = 0; k < 128; ++k) S[k] = s0[(size_t)k * HD]; }
    else {
#pragma unroll
        for (int k = 0; k < 128; ++k) S[k] = 0.f; }
    for (int t = 0; t < T; ++t) {
        const int row = row0 + t;
        const float g = ab[(size_t)row * 16 + h], beta = ab[(size_t)row * 16 + 8 + h], e = __expf(g);
        const v4u* kp = (const v4u*)(qc + (size_t)row * DCONV + 1024 + h * HD); const v4u* qp = (const v4u*)(qc + (size_t)row * DCONV + h * HD);
        const float vv = pg8::bf2f(qc[(size_t)row * DCONV + 2048 + h * HD + dv]);
        float ks = 0.f;
#pragma unroll
        for (int c = 0; c < 16; ++c) { const v4u kw = kp[c];
#pragma unroll
            for (int i = 0; i < 4; ++i) { ks += bflo(kw[i]) * S[8 * c + 2 * i]; ks += bfhi(kw[i]) * S[8 * c + 2 * i + 1]; }
            if ((c & 3) == 3) asm volatile("" ::: "memory"); }
        const float dlt = beta * (vv - e * ks);
        float o = 0.f;
#pragma unroll
        for (int c = 0; c < 16; ++c) { const v4u kw = kp[c], qw = qp[c];
#pragma unroll
            for (int i = 0; i < 4; ++i) {
                S[8 * c + 2 * i] = e * S[8 * c + 2 * i] + bflo(kw[i]) * dlt; o += bflo(qw[i]) * S[8 * c + 2 * i];
                S[8 * c + 2 * i + 1] = e * S[8 * c + 2 * i + 1] + bfhi(kw[i]) * dlt; o += bfhi(qw[i]) * S[8 * c + 2 * i + 1]; }
            if ((c & 1) == 1) asm volatile("" ::: "memory"); }
        oraw[(size_t)row * DM + h * HD + dv] = o;
    }
    float* so = (smp ? F.out + O_SDS + (((size_t)l * NS + seq) * NH + h) * HD * HD : F.out + O_SDP + (((size_t)l * NB + seq) * NH + h) * HD * HD) + dv;
#pragma unroll
    for (int k = 0; k < 128; ++k) so[(size_t)k * HD] = S[k];
}
DI void d_phase(Frame& F, int l) {
    if (F.bid < 16) { const int u = F.bid * NWAVES + F.wave; d_unit(F, l, false, u >> 4, (u >> 1) & 7, u & 1); return; }
    const int gw = (F.bid - 16) * NWAVES + F.wave, NGW = (F.G - 16) * NWAVES;
    for (int u = gw; u < NS * NH * 2; u += NGW) d_unit(F, l, true, u >> 4, (u >> 1) & 7, u & 1);
    for (int row = gw; row < TT; row += NGW) e2_ln_row(F, l, row);
}
DI void e3_phase(Frame& F, int l) {
    const int gw = F.bid * NWAVES + F.wave, NGW = F.G * NWAVES;
    const float* oraw = (const float*)(F.ws + WS_A); const bf16* z = (const bf16*)(F.ws + WS_C); bf16* oab = (bf16*)(F.ws + WS_B);
    const bf16* vn = (const bf16*)(F.ws + WS_A + 68 * MiB); const bf16* uv = (const bf16*)(F.ws + WS_D);
    const float* dnw = F.in[9] + l * HD; const float* wsp = F.in[12] + (size_t)l * NH * 128 * 128; const float* bsp = F.in[13] + (size_t)l * NH * 128;
    for (int it = gw; it < TT * 16; it += NGW) {
        const int row = it >> 4, sub = it & 15;
        if (sub < 8) { const int h = sub, c = h * HD + 2 * F.lane;
            const float o0 = oraw[(size_t)row * DM + c], o1 = oraw[(size_t)row * DM + c + 1];
            const float rs = rsq_(wave_sum(o0 * o0 + o1 * o1) * (1.0f / HD) + 1e-6f);
            const unsigned zw = *(const unsigned*)(z + (size_t)row * DM + c);
            *(unsigned*)(oab + (size_t)row * 2048 + c) = pk2(o0 * rs * dnw[2 * F.lane] * siluf_(bflo(zw)), o1 * rs * dnw[2 * F.lane + 1] * siluf_(bfhi(zw)));
        } else { const int g = sub - 8, ch = g * 128 + 2 * F.lane;
            const bool smp = row >= TP; const int i = smp ? (row - TP) % TS_ : row % 128, c0 = row - i;
            const float* wr = wsp + ((size_t)g * 128 + i) * 128; float a0 = 0.f, a1 = 0.f;
            for (int j = 0; j <= i; ++j) { const float w = wr[j]; const unsigned vw = *(const unsigned*)(vn + (size_t)(c0 + j) * DB + ch); a0 += w * bflo(vw); a1 += w * bfhi(vw); }
            const float b = bsp[g * 128 + i]; const unsigned uw = *(const unsigned*)(uv + (size_t)row * 2048 + ch);
            *(unsigned*)(oab + (size_t)row * 2048 + 1024 + ch) = pk2(bflo(uw) * (a0 + b), bfhi(uw) * (a1 + b));
        }
    }
}

constexpr int PH_PER_LAYER = 10, N_PHASES = 1 + DEPTH * PH_PER_LAYER;
__global__ void __launch_bounds__(NWAVES * 64, 2) mega_fwd(Args args) {
    extern __shared__ __attribute__((aligned(16))) unsigned char lds_raw[];
    Frame F; F.lds = (LAS unsigned char*)lds_raw; F.tid = threadIdx.x; F.lane = F.tid & 63; F.wave = __builtin_amdgcn_readfirstlane(F.tid >> 6);
    F.G = gridDim.x; F.bid = blockIdx.x; F.out = args.out; F.ws = args.ws;
#if MK_ONE_LAUNCH
    cg::grid_group grid = cg::this_grid();
#define SEAM(k) do { if ((k) + 1 < hi) grid.sync(); } while (0)
#else
#define SEAM(k) do { } while (0)
#endif
#ifndef PH_MASK
#define PH_MASK 0x7ff
#endif
#define EN(j) ((PH_MASK >> (j)) & 1)
    const int lo = args.ph_lo, hi = args.ph_hi;
    unsigned char* ws = args.ws;
#pragma unroll 1
    for (int p = lo; p < hi; ++p) {
        { unsigned char* w_ = args.ws; float* o_ = args.out; int t_ = threadIdx.x; asm volatile("" : "+s"(w_), "+s"(o_), "+v"(t_)); ws = w_; F.ws = w_; F.out = o_;
          F.tid = t_; F.lane = t_ & 63; F.wave = __builtin_amdgcn_readfirstlane(t_ >> 6); }
        if (p == 0) { if (EN(10)) { p0_weights(F); p0_rows(F); } }
        else {
            const int l = (p - 1) / PH_PER_LAYER, j = (p - 1) % PH_PER_LAYER; unsigned char* wl = ws + WS_W + (size_t)l * W_LAYER;
            int gk = -1;
            if (j == 0 || j == 4 || j == 5 || j == 7 || j == 8) gk = j;
            else if (j == 1) { if (EN(1)) e1_conv(F, l); }
            else if (j == 2) { if (EN(2)) d_phase(F, l); }
            else if (j == 3) { if (EN(3)) e3_phase(F, l); }
            else if (EN(6)) { const bool r1 = (j == 6); rows_residual(F, (const float*)(ws + WS_D), (r1 ? F.in[17] : F.in[21]) + l * DM, r1 && l == 0, !r1 && l == DEPTH - 1, r1 ? -1 : l + 1); }
            if (EN(0) && gk >= 0) {
                pg8::Gemm g; pg8::EpiAny E; E.mid_t = -1; E.ws = ws;
                if (gk == 0)      { g = pg8::Gemm{(const bf16*)(ws + WS_XB), (const bf16*)(wl + W_IN), TT, 8192, DM}; E.kind = 0; }
                else if (gk == 4) { g = pg8::Gemm{(const bf16*)(ws + WS_B), (const bf16*)(wl + W_PAB), TT, DM, 2048}; E.kind = 1; E.mid_t = 16; }
                else if (gk == 5) { g = pg8::Gemm{(const bf16*)(ws + WS_C), (const bf16*)(wl + W_OUT), TT, DM, DM}; E.kind = 2; }
                else if (gk == 7) { g = pg8::Gemm{(const bf16*)(ws + WS_XB), (const bf16*)(wl + W_FIN), TT, 2 * DFF, DM}; E.kind = 3; }
                else              { g = pg8::Gemm{(const bf16*)(ws + WS_A), (const bf16*)(wl + W_FOUT), TT, DM, DFF}; E.kind = 2; }
                pg8::StaticOrder S; S.init(g.M, g.N, F.G, F.bid);
                pg8::gemm_phase<pg8::EpiAny, pg8::StaticOrder, true, true>(F.lds, g, S, E);
            }
        }
        SEAM(p);
    }
#undef SEAM
}

extern "C" void kernel_launch(void* const* d_in, const int* in_sizes, int n_in, void* d_out, int out_size, void* d_ws, size_t ws_size, hipStream_t stream) {
    static int grid = 0;
    if (grid == 0) {
        if (n_in != 22 || (size_t)out_size != O_END || ws_size < WS_END) { fprintf(stderr, "kernel_launch: unexpected shapes: n_in %d out %d (want %zu) ws %zu (need %zu)\n", n_in, out_size, (size_t)O_END, ws_size, (size_t)WS_END); grid = -1; return; }
        int dev = 0, cus = 0, per_cu = 0;
        if (hipGetDevice(&dev) != hipSuccess || hipDeviceGetAttribute(&cus, hipDeviceAttributeMultiprocessorCount, dev) != hipSuccess) { grid = -1; return; }
        if (hipFuncSetAttribute((const void*)mega_fwd, hipFuncAttributeMaxDynamicSharedMemorySize, LDS_BYTES) != hipSuccess) { fprintf(stderr, "kernel_launch: hipFuncSetAttribute failed\n"); grid = -1; return; }
        if (hipOccupancyMaxActiveBlocksPerMultiprocessor(&per_cu, (const void*)mega_fwd, NWAVES * 64, LDS_BYTES) != hipSuccess || per_cu < 1) { fprintf(stderr, "kernel_launch: occupancy query says %d\n", per_cu); per_cu = 1; }
        (void)hipGetLastError();
        grid = cus;
        if (grid < 32) { fprintf(stderr, "kernel_launch: grid %d too small\n", grid); grid = -1; return; }
    }
    if (grid < 0) return;
    Args a{};
    for (int i = 0; i < 22; ++i) a.in[i] = (const float*)d_in[i];
    a.out = (float*)d_out; a.ws = (unsigned char*)d_ws;
#if MK_ONE_LAUNCH
    a.ph_lo = 0; a.ph_hi = N_PHASES;
    void* kargs[] = {&a};
    hipError_t e = hipLaunchCooperativeKernel((void*)mega_fwd, dim3(grid), dim3(NWAVES * 64), kargs, LDS_BYTES, stream);
    if (e != hipSuccess) fprintf(stderr, "cooperative launch failed: %s (grid %d)\n", hipGetErrorString(e), grid);
#else
    for (int p = 0; p < N_PHASES; ++p) { a.ph_lo = p; a.ph_hi = p + 1; hipLaunchKernelGGL(mega_fwd, dim3(grid), dim3(NWAVES * 64), LDS_BYTES, stream, a); }
#endif
}
```

```cpp
#include <hip/hip_runtime.h>
#include <hip/hip_cooperative_groups.h>
#include <cstdio>
#include <cstdint>
namespace cg = cooperative_groups;

#ifndef MK_ONE_LAUNCH
#define MK_ONE_LAUNCH 1
#endif

constexpr int NWAVES = 8;
constexpr int DM = 1024, NB = 8, SEQ = 2048, DEPTH = 2, NS = 128, TS_ = 8, NH = 8, HD = 128, DCONV = 3072, DB = 1024, DFF = 2816, DIN = 8208;
constexpr int TP = NB * SEQ, TSM = NS * TS_, TT = TP + TSM;
constexpr size_t O_YP = 0, O_YS = (size_t)TP * DM, O_SDP = O_YS + (size_t)TSM * DM, O_SCP = O_SDP + (size_t)DEPTH * NB * NH * HD * HD,
                 O_CVP = O_SCP + (size_t)DEPTH * NB * 3 * DCONV, O_SDS = O_CVP + (size_t)DEPTH * NB * 128 * DB, O_SCS = O_SDS + (size_t)DEPTH * NS * NH * HD * HD,
                 O_CVS = O_SCS + (size_t)DEPTH * NS * 3 * DCONV, O_END = O_CVS + (size_t)DEPTH * NS * TS_ * DB;
constexpr size_t MiB = 1u << 20;
constexpr int LD_OAB = 2112, LD_PAB = 2112;
constexpr size_t WS_CTL = 0, WS_AB = 1 * MiB, WS_RSTD = 3 * MiB, WS_EG = 3 * MiB + 512 * 1024, WS_W = 4 * MiB, W_LAYER = 41 * MiB;
constexpr size_t W_IN = 0, W_PAB = 17 * MiB, W_OUT = 21 * MiB + 256 * 1024, W_FIN = 23 * MiB + 512 * 1024, W_FOUT = 35 * MiB + 256 * 1024, W_SP = 40 * MiB + 768 * 1024;
constexpr size_t WS_A = 86 * MiB, WS_C = 188 * MiB, WS_D = 222 * MiB, WS_E = 290 * MiB, WS_REC = 358 * MiB, WS_QKVS = 502 * MiB, WS_END = 508 * MiB;
constexpr size_t WS_QKVRAW = WS_A, WS_ORAW = WS_A, WS_H = WS_A, WS_Z = WS_C, WS_MERGED = WS_C, WS_UV = WS_D, WS_Y = WS_D, WS_GT = WS_E,
                 WS_XB = WS_REC, WS_OAB = WS_A;
constexpr int REC_BYTES = 73728, R_WN = 0, R_QG = 16384, R_KGT = 32768, R_QK = 49152, R_U = 57344, REC_FRAG_BYTES = 57344;
constexpr int LDS_BYTES = 163840;

namespace pg8 {
#define PG8_LAS __attribute__((address_space(3)))
typedef unsigned short bf16_t;
typedef short bf16x8 __attribute__((ext_vector_type(8)));
typedef float f32x4 __attribute__((ext_vector_type(4)));
typedef unsigned u32x4 __attribute__((ext_vector_type(4)));
constexpr int BM = 256, BK = 64, HALF = 128, HTB = HALF * BK * 2, STAGE_BYTES = 8 * HTB, NXCD = 8, WGM = 8;

__host__ __device__ __forceinline__ int lds_byte(int r, int c) { const int st = (r >> 4) * 2 + (c >> 5), rr = r & 15, cc = c & 31, ob = rr * 64 + cc * 2; return st * 1024 + (ob ^ (((ob >> 9) & 1) << 5)); }
__host__ __device__ __forceinline__ void stage_rc(int b, int& R, int& C) { const int st = b / 1024, sb = b % 1024, swz = sb ^ (((sb >> 9) & 1) << 5); R = (st >> 1) * 16 + swz / 64; C = (st & 1) * 32 + (swz % 64) / 2; }
__host__ __device__ __forceinline__ int perm32(int rho) { const int n = rho >> 4, i = rho & 15; return 8 * (i >> 2) + 4 * n + (i & 3); }

struct Unit { int pm, pn, qm; };
struct Gemm { const bf16_t* A; const bf16_t* Bt; int M, N, K, lda, ldb; };

struct StaticOrder {
    int nM, nN, nwg, G, c, pmaj;
    __host__ __device__ void init(int M, int N, int G_, int c_) { nM = M / BM; nN = N / BM; nwg = nM * nN; G = G_; c = c_; pmaj = 0; }
    __host__ __device__ bool next(int i, Unit& u) const {
        if (pmaj) {
            if (i > 0 || c >= 256) return false; const int x = c & 7, slot = c >> 3; u.pm = (slot >> 2) * 8 + x; u.pn = slot & 3; u.qm = 15; return true; }
        long L = (long)i * G + c; u.qm = 15;
        { const int full = nwg / G, rem = nwg - full * G;
          if (rem > 0 && i == full) {
              if (4 * rem <= G) { if (c >= 4 * rem) return false; L = (long)full * G + (c >> 2); u.qm = 1 << (c & 3); }
              else if (2 * rem <= G) { if (c >= 2 * rem) return false; L = (long)full * G + (c >> 1); u.qm = (c & 1) ? 12 : 3; } } }
        if (L >= nwg) return false;
        int wgid = (int)L; { const int q = nwg / NXCD, r = nwg % NXCD, xcd = wgid % NXCD, off = wgid / NXCD; wgid = (xcd < r ? xcd * (q + 1) : r * (q + 1) + (xcd - r) * q) + off; }
        const int nig = WGM * nN, gid = wgid / nig, fm = gid * WGM, gsz = (nM - fm) < WGM ? (nM - fm) : WGM;
        u.pm = fm + ((wgid % nig) % gsz); u.pn = (wgid % nig) / gsz; return true;
    }
    __device__ __forceinline__ void a_ready(const Unit&) const {}
    __device__ __forceinline__ void done(const Unit&) const {}
};

__device__ __forceinline__ unsigned cvt_pk_bf16(float lo, float hi) { unsigned r; asm volatile("v_cvt_pk_bf16_f32 %0, %1, %2" : "=v"(r) : "v"(lo), "v"(hi)); return r; }
typedef float f32x2 __attribute__((ext_vector_type(2)));
__device__ __forceinline__ f32x2 gelu_pk(f32x2 v) {
    const f32x2 av = __builtin_elementwise_abs(v), d = av * 0.2316418882f + 1.0f;
    f32x2 t; t.x = __builtin_amdgcn_rcpf(d.x); t.y = __builtin_amdgcn_rcpf(d.y);
    f32x2 q = t * 0.5307027145f + (-0.7265760135f); q = q * t + 0.7107068705f; q = q * t + (-0.142248368f); q = q * t + 0.127414796f; q = q * t;
    const f32x2 s = (v * v) * (-0.72134752044f);
    f32x2 e; e.x = __builtin_amdgcn_exp2f(s.x); e.y = __builtin_amdgcn_exp2f(s.y);
    const f32x2 m = v * (q * e), r = v - m;
    f32x2 o; o.x = v.x < 0.f ? m.x : r.x; o.y = v.y < 0.f ? m.y : r.y; return o;
}
__device__ __forceinline__ float sigm(float x) { return __builtin_amdgcn_rcpf(1.0f + __expf(-x)); }
__device__ __forceinline__ float bf2f(unsigned short u) { return __uint_as_float((unsigned)u << 16); }


struct EpiProj {
    static constexpr bool PERM = true, AFTER_DRAIN = false; static constexpr int MID_T = 0;
    unsigned char* ws;
    __device__ __forceinline__ void mid(f32x4 (&acc)[2][2][4][2], const Unit& u, int wr, int wc, int fr, int fq) const {}
    __device__ __forceinline__ void operator()(const f32x4 (&acc)[2][2][4][2], const Unit& u, int wr, int wc, int fr, int fq) const {
        const int row0 = u.pm * BM + wr * 64 + fr; const int pn = u.pn;
        bf16_t* base; int ld, colt; bool act = false;
        if (pn < 12) { base = (bf16_t*)(ws + WS_QKVRAW); ld = 3072; colt = pn * BM; }
        else if (pn < 16) { base = (bf16_t*)(ws + WS_Z); ld = 1024; colt = (pn - 12) * BM; }
        else if (pn < 24) { base = (bf16_t*)(ws + WS_UV); ld = 2048; colt = (pn - 16) * BM; act = true; }
        else { base = (bf16_t*)(ws + WS_GT); ld = 2048; colt = (pn - 24) * BM; }
        const int col0 = colt + wc * 32 + 8 * fq;
#pragma unroll
        for (int ai = 0; ai < 2; ++ai)
#pragma unroll
            for (int m = 0; m < 4; ++m) { if (!((u.qm >> (2 * ai)) & 3)) continue; const int row = row0 + ai * HALF + m * 16; bf16_t* rowp = base + (size_t)row * ld + col0;
#pragma unroll
                for (int bj = 0; bj < 2; ++bj) { if (!((u.qm >> (2 * ai + bj)) & 1)) continue; f32x4 v0 = acc[ai][bj][m][0], v1 = acc[ai][bj][m][1];
                    if (act) { f32x2 a = gelu_pk((f32x2){v0[0], v0[1]}), b = gelu_pk((f32x2){v0[2], v0[3]}), c = gelu_pk((f32x2){v1[0], v1[1]}), d = gelu_pk((f32x2){v1[2], v1[3]});
                        v0 = (f32x4){a.x, a.y, b.x, b.y}; v1 = (f32x4){c.x, c.y, d.x, d.y}; }
                    u32x4 w; w.x = cvt_pk_bf16(v0[0], v0[1]); w.y = cvt_pk_bf16(v0[2], v0[3]); w.z = cvt_pk_bf16(v1[0], v1[1]); w.w = cvt_pk_bf16(v1[2], v1[3]);
                    *(u32x4*)(rowp + bj * HALF) = w; } }
    }
};
struct EpiMerge {
    static constexpr bool PERM = true, AFTER_DRAIN = false; static constexpr int MID_T = 16;
    unsigned char* ws;
    __device__ __forceinline__ void mid(f32x4 (&acc)[2][2][4][2], const Unit& u, int wr, int wc, int fr, int fq) const {
        int row0 = u.pm * BM + wr * 64 + fr, col0 = u.pn * BM + wc * 32 + 8 * fq;
        asm volatile("" : "+v"(row0), "+v"(col0));
        const bf16_t* GT = (const bf16_t*)(ws + WS_GT);
#pragma unroll
        for (int ai = 0; ai < 2; ++ai) {
            u32x4 ga[4][2], gb[4][2];
#pragma unroll
            for (int m = 0; m < 4; ++m) { const bf16_t* gp = GT + (size_t)(row0 + ai * HALF + m * 16) * 2048 + col0;
#pragma unroll
                for (int bj = 0; bj < 2; ++bj) { ga[m][bj] = *(const u32x4*)(gp + bj * HALF); gb[m][bj] = *(const u32x4*)(gp + 1024 + bj * HALF); } }
#pragma unroll
            for (int m = 0; m < 4; ++m)
#pragma unroll
                for (int bj = 0; bj < 2; ++bj)
#pragma unroll
                    for (int n = 0; n < 2; ++n)
#pragma unroll
                        for (int e = 0; e < 4; ++e) { const unsigned wa = ga[m][bj][n * 2 + (e >> 1)], wb = gb[m][bj][n * 2 + (e >> 1)];
                            const float a = (e & 1) ? __uint_as_float(wa & 0xffff0000u) : __uint_as_float(wa << 16), b = (e & 1) ? __uint_as_float(wb & 0xffff0000u) : __uint_as_float(wb << 16);
                            acc[ai][bj][m][n][e] *= (1.0f + __expf(-b)) * __builtin_amdgcn_rcpf(1.0f + __expf(-a)); }
            asm volatile("" ::: "memory");
        }
    }
    __device__ __forceinline__ void operator()(const f32x4 (&acc)[2][2][4][2], const Unit& u, int wr, int wc, int fr, int fq) const {
        const int row0 = u.pm * BM + wr * 64 + fr, col0 = u.pn * BM + wc * 32 + 8 * fq; const bf16_t* GT = (const bf16_t*)(ws + WS_GT); bf16_t* O = (bf16_t*)(ws + WS_MERGED);
#pragma unroll
        for (int ai = 0; ai < 2; ++ai) {
            u32x4 gb[4][2];
#pragma unroll
            for (int m = 0; m < 4; ++m)
#pragma unroll
                for (int bj = 0; bj < 2; ++bj) gb[m][bj] = *(const u32x4*)(GT + (size_t)(row0 + ai * HALF + m * 16) * 2048 + 1024 + col0 + bj * HALF);
#pragma unroll
            for (int m = 0; m < 4; ++m) { const int row = row0 + ai * HALF + m * 16; bf16_t* rowp = O + (size_t)row * 1024 + col0;
#pragma unroll
                for (int bj = 0; bj < 2; ++bj) { float o[8];
#pragma unroll
                    for (int n = 0; n < 2; ++n)
#pragma unroll
                        for (int e = 0; e < 4; ++e) { const unsigned wb = gb[m][bj][n * 2 + (e >> 1)]; const float b = (e & 1) ? __uint_as_float(wb & 0xffff0000u) : __uint_as_float(wb << 16);
                            o[n * 4 + e] = acc[ai][bj][m][n][e] * sigm(b); }
                    u32x4 w; w.x = cvt_pk_bf16(o[0], o[1]); w.y = cvt_pk_bf16(o[2], o[3]); w.z = cvt_pk_bf16(o[4], o[5]); w.w = cvt_pk_bf16(o[6], o[7]);
                    *(u32x4*)(rowp + bj * HALF) = w; } }
        }
    }
};
struct EpiF32 {
    static constexpr bool PERM = true, AFTER_DRAIN = false; static constexpr int MID_T = 0;
    unsigned char* ws;
    __device__ __forceinline__ void mid(f32x4 (&acc)[2][2][4][2], const Unit& u, int wr, int wc, int fr, int fq) const {}
    __device__ __forceinline__ void operator()(const f32x4 (&acc)[2][2][4][2], const Unit& u, int wr, int wc, int fr, int fq) const {
        const int row0 = u.pm * BM + wr * 64 + fr, col0 = u.pn * BM + wc * 32 + 8 * fq; bf16_t* Y = (bf16_t*)(ws + WS_Y); constexpr int ldc = DM;
#pragma unroll
        for (int ai = 0; ai < 2; ++ai)
#pragma unroll
            for (int m = 0; m < 4; ++m) { if (!((u.qm >> (2 * ai)) & 3)) continue; bf16_t* rowp = Y + (size_t)(row0 + ai * HALF + m * 16) * ldc + col0;
#pragma unroll
                for (int bj = 0; bj < 2; ++bj) { if (!((u.qm >> (2 * ai + bj)) & 1)) continue; const f32x4 v0 = acc[ai][bj][m][0], v1 = acc[ai][bj][m][1];
                    u32x4 w; w.x = cvt_pk_bf16(v0[0], v0[1]); w.y = cvt_pk_bf16(v0[2], v0[3]); w.z = cvt_pk_bf16(v1[0], v1[1]); w.w = cvt_pk_bf16(v1[2], v1[3]);
                    *(u32x4*)(rowp + bj * HALF) = w; } }
    }
};
struct EpiSwiglu {
    static constexpr bool PERM = true, AFTER_DRAIN = false; static constexpr int MID_T = 0;
    unsigned char* ws;
    __device__ __forceinline__ void mid(f32x4 (&acc)[2][2][4][2], const Unit& u, int wr, int wc, int fr, int fq) const {}
    __device__ __forceinline__ void operator()(const f32x4 (&acc)[2][2][4][2], const Unit& u, int wr, int wc, int fr, int fq) const {
        const int row0 = u.pm * BM + wr * 64 + fr, col0 = u.pn * HALF + wc * 32 + 8 * fq; bf16_t* Hh = (bf16_t*)(ws + WS_H); constexpr int ldh = DFF;
#pragma unroll
        for (int ai = 0; ai < 2; ++ai)
#pragma unroll
            for (int m = 0; m < 4; ++m) { if (!((u.qm >> (2 * ai)) & 3)) continue; const int row = row0 + ai * HALF + m * 16; float o[8];
#pragma unroll
                for (int n = 0; n < 2; ++n)
#pragma unroll
                    for (int e = 0; e < 4; ++e) { const float g = acc[ai][0][m][n][e], up = acc[ai][1][m][n][e]; o[n * 4 + e] = g * sigm(g) * up; }
                u32x4 w; w.x = cvt_pk_bf16(o[0], o[1]); w.y = cvt_pk_bf16(o[2], o[3]); w.z = cvt_pk_bf16(o[4], o[5]); w.w = cvt_pk_bf16(o[6], o[7]);
                *(u32x4*)(Hh + (size_t)row * ldh + col0) = w; }
    }
};

struct EpiAny {
    static constexpr bool PERM = true, AFTER_DRAIN = false; static constexpr int MID_T = 1;
    int kind, mid_t;
    unsigned char* ws;
    __device__ __forceinline__ void mid(f32x4 (&acc)[2][2][4][2], const Unit& u, int wr, int wc, int fr, int fq) const { EpiMerge{ws}.mid(acc, u, wr, wc, fr, fq); }
    __device__ __forceinline__ void operator()(const f32x4 (&acc)[2][2][4][2], const Unit& u, int wr, int wc, int fr, int fq) const {
        if (kind == 0) EpiProj{ws}(acc, u, wr, wc, fr, fq); else if (kind == 1) EpiMerge{ws}(acc, u, wr, wc, fr, fq); else if (kind == 2) EpiF32{ws}(acc, u, wr, wc, fr, fq); else EpiSwiglu{ws}(acc, u, wr, wc, fr, fq);
    }
};

template <class Epi, class Sched, bool ALIGN_EPI = false, bool SP2 = false>
__device__ __forceinline__ void gemm_phase(PG8_LAS unsigned char* lds, const Gemm g, const Sched& S, const Epi& E) {
    int tid_ = threadIdx.x; asm volatile("" : "+v"(tid_));
    const int tid = tid_, wid = __builtin_amdgcn_readfirstlane(tid >> 6), lane = tid & 63, wr = wid >> 2, wc = wid & 3, fr = lane & 15, fq = lane >> 4;
    const int K = g.K, nt = K / BK;
    unsigned voffA[2], voffB[2];
#pragma unroll
    for (int i = 0; i < 2; ++i) { int R, C; stage_rc(tid * 16 + i * 8192, R, C); const int Rb = Epi::PERM ? ((R & ~31) + perm32(R & 31)) : R;
        voffA[i] = (unsigned)(R * g.lda + C) * 2u; voffB[i] = (unsigned)(Rb * g.ldb + C) * 2u; }
    const size_t kstep = (size_t)(BK * 2);
    const size_t hstepA = (size_t)HALF * g.lda * 2, hstepB = (size_t)HALF * g.ldb * 2;
    const size_t tstepA = 2 * hstepA, tstepB = 2 * hstepB;
    const unsigned ldsw = (unsigned)wid * 1024u;
    const int aoff = lds_byte(wr * 64 + fr, fq * 8), boff = lds_byte(wc * 32 + fr, fq * 8);
#define PG8_SA(b, h) (((b) * 2 + (h)) * HTB)
#define PG8_SB(b, h) ((4 + (b) * 2 + (h)) * HTB)
#define PG8_STAGE(bufoff, gbase, voff) do { _Pragma("unroll") for (int _i = 0; _i < 2; ++_i) \
        __builtin_amdgcn_global_load_lds((const unsigned*)((const char*)(gbase) + (voff)[_i]), (PG8_LAS unsigned*)(lds + (bufoff) + ldsw + _i * 8192), 16, 0, 0); } while (0)
#define PG8_LDA(dst, b, h) do { _Pragma("unroll") for (int m = 0; m < 4; ++m) _Pragma("unroll") for (int k = 0; k < 2; ++k) dst[m][k] = *(const PG8_LAS bf16x8*)(lds + PG8_SA(b, h) + aoff + m * 2048 + k * 1024); } while (0)
#define PG8_LDB(dst, b, h) do { _Pragma("unroll") for (int n = 0; n < 2; ++n) _Pragma("unroll") for (int k = 0; k < 2; ++k) dst[n][k] = *(const PG8_LAS bf16x8*)(lds + PG8_SB(b, h) + boff + n * 2048 + k * 1024); } while (0)
#define PG8_MMA(ai, bj, At, Bt) do { __builtin_amdgcn_s_setprio(1); _Pragma("unroll") for (int m = 0; m < 4; ++m) _Pragma("unroll") for (int n = 0; n < 2; ++n) _Pragma("unroll") for (int k = 0; k < 2; ++k) \
        acc[ai][bj][m][n] = __builtin_amdgcn_mfma_f32_16x16x32_bf16(Bt[n][k], At[m][k], acc[ai][bj][m][n], 0, 0, 0); __builtin_amdgcn_s_setprio(0); } while (0)
#define PG8_WAIT_V(n) asm volatile("s_waitcnt vmcnt(" #n ")" ::: "memory")
#define PG8_WAIT_L(n) asm volatile("s_waitcnt lgkmcnt(" #n ")" ::: "memory")
#define PG8_BAR __builtin_amdgcn_s_barrier()
#define PG8_SCHED __builtin_amdgcn_sched_barrier(0)
    Unit cur, nxt; int ui = 0;
    if (!S.next(0, cur)) return;
    f32x4 acc[2][2][4][2];
#pragma unroll
    for (int a = 0; a < 2; ++a)
#pragma unroll
        for (int b = 0; b < 2; ++b)
#pragma unroll
            for (int m = 0; m < 4; ++m)
#pragma unroll
                for (int n = 0; n < 2; ++n) acc[a][b][m][n] = (f32x4){0.f, 0.f, 0.f, 0.f};
    bf16x8 At[4][2], B0[2][2], B1[2][2];
    const char* cA = (const char*)g.A + (size_t)cur.pm * tstepA; const char* cB = (const char*)g.Bt + (size_t)cur.pn * tstepB;
    S.a_ready(cur);
    if constexpr (SP2) {
        PG8_STAGE(PG8_SB(0, 0), cB, voffB); PG8_STAGE(PG8_SB(0, 1), cB + hstepB, voffB); PG8_STAGE(PG8_SA(0, 0), cA, voffA); PG8_STAGE(PG8_SA(0, 1), cA + hstepA, voffA);
        if (wr == 1) PG8_BAR;
        PG8_WAIT_V(2); PG8_BAR;
        PG8_STAGE(PG8_SB(1, 0), cB + kstep, voffB); PG8_STAGE(PG8_SA(1, 0), cA + kstep, voffA); PG8_STAGE(PG8_SB(1, 1), cB + hstepB + kstep, voffB);
        PG8_WAIT_V(6); PG8_BAR;
    } else {
        PG8_STAGE(PG8_SB(0, 0), cB, voffB); PG8_STAGE(PG8_SA(0, 0), cA, voffA); PG8_STAGE(PG8_SB(0, 1), cB + hstepB, voffB); PG8_STAGE(PG8_SA(0, 1), cA + hstepA, voffA);
        if (wr == 1) PG8_BAR;
        PG8_WAIT_V(4); PG8_BAR;
        PG8_STAGE(PG8_SB(1, 0), cB + kstep, voffB); PG8_STAGE(PG8_SA(1, 0), cA + kstep, voffA); PG8_STAGE(PG8_SB(1, 1), cB + hstepB + kstep, voffB);
        PG8_WAIT_V(6); PG8_BAR;
    }
    for (;;) {
        const bool has_next = S.next(ui + 1, nxt);
        const char* nA = has_next ? (const char*)g.A + (size_t)nxt.pm * tstepA : cA; const char* nB = has_next ? (const char*)g.Bt + (size_t)nxt.pn * tstepB : cB;
        for (int t = 0; t < nt; t += 2) {
            const bool last = (t == nt - 2);
            const char* a1 = cA + (size_t)(t + 1) * kstep;
            const char* a2 = last ? nA : cA + (size_t)(t + 2) * kstep; const char* b2 = last ? nB : cB + (size_t)(t + 2) * kstep;
            const char* a3 = a2 + kstep; const char* b3 = b2 + kstep;
            if (last && has_next) S.a_ready(nxt);
            if constexpr (Epi::MID_T > 0) { if (t == E.mid_t) E.mid(acc, cur, wr, wc, fr, fq); }
            if constexpr (SP2) {
            PG8_LDB(B0, 0, 0); PG8_LDB(B1, 0, 1); PG8_SCHED; PG8_LDA(At, 0, 0); PG8_STAGE(PG8_SA(1, 1), a1 + hstepA, voffA);
            PG8_WAIT_V(8); PG8_WAIT_L(0); PG8_BAR; if (cur.qm & 1) PG8_MMA(0, 0, At, B0); if (cur.qm & 2) PG8_MMA(0, 1, At, B1); PG8_BAR; PG8_SCHED;
            PG8_LDA(At, 0, 1); PG8_STAGE(PG8_SB(0, 0), b2, voffB); PG8_STAGE(PG8_SB(0, 1), b2 + hstepB, voffB); PG8_STAGE(PG8_SA(0, 0), a2, voffA);
            PG8_WAIT_V(8); PG8_WAIT_L(0); PG8_BAR; if (cur.qm & 4) PG8_MMA(1, 0, At, B0); if (cur.qm & 8) PG8_MMA(1, 1, At, B1); PG8_BAR; PG8_SCHED;
            PG8_LDB(B0, 1, 0); PG8_LDB(B1, 1, 1); PG8_SCHED; PG8_LDA(At, 1, 0); PG8_STAGE(PG8_SA(0, 1), a2 + hstepA, voffA);
            PG8_WAIT_V(8); PG8_WAIT_L(0); PG8_BAR; if (cur.qm & 1) PG8_MMA(0, 0, At, B0); if (cur.qm & 2) PG8_MMA(0, 1, At, B1); PG8_BAR; PG8_SCHED;
            PG8_LDA(At, 1, 1); PG8_STAGE(PG8_SB(1, 0), b3, voffB); PG8_STAGE(PG8_SB(1, 1), b3 + hstepB, voffB); PG8_STAGE(PG8_SA(1, 0), a3, voffA);
            PG8_WAIT_V(8); PG8_WAIT_L(0); PG8_BAR; if (cur.qm & 4) PG8_MMA(1, 0, At, B0); if (cur.qm & 8) PG8_MMA(1, 1, At, B1); PG8_BAR; PG8_SCHED;
            } else {
            PG8_LDB(B0, 0, 0); PG8_SCHED; PG8_LDA(At, 0, 0); PG8_STAGE(PG8_SA(1, 1), a1 + hstepA, voffA);
            PG8_WAIT_L(8); PG8_BAR; PG8_WAIT_L(0); PG8_MMA(0, 0, At, B0); PG8_BAR; PG8_SCHED;
            PG8_LDB(B1, 0, 1); PG8_STAGE(PG8_SB(0, 0), b2, voffB);
            PG8_BAR; PG8_WAIT_L(0); PG8_MMA(0, 1, At, B1); PG8_BAR;
            PG8_LDA(At, 0, 1); PG8_STAGE(PG8_SA(0, 0), a2, voffA);
            PG8_BAR; PG8_WAIT_L(0); PG8_MMA(1, 0, At, B0); PG8_BAR; PG8_SCHED;
            PG8_STAGE(PG8_SB(0, 1), b2 + hstepB, voffB);
            PG8_WAIT_V(6); PG8_BAR; PG8_MMA(1, 1, At, B1); PG8_BAR;
            PG8_LDB(B0, 1, 0); PG8_SCHED; PG8_LDA(At, 1, 0); PG8_STAGE(PG8_SA(0, 1), a2 + hstepA, voffA);
            PG8_WAIT_L(8); PG8_BAR; PG8_WAIT_L(0); PG8_MMA(0, 0, At, B0); PG8_BAR; PG8_SCHED;
            PG8_LDB(B1, 1, 1); PG8_STAGE(PG8_SB(1, 0), b3, voffB);
            PG8_BAR; PG8_WAIT_L(0); PG8_MMA(0, 1, At, B1); PG8_BAR;
            PG8_LDA(At, 1, 1); PG8_STAGE(PG8_SA(1, 0), a3, voffA);
            PG8_BAR; PG8_WAIT_L(0); PG8_MMA(1, 0, At, B0); PG8_BAR; PG8_SCHED;
            PG8_STAGE(PG8_SB(1, 1), b3 + hstepB, voffB);
            PG8_WAIT_V(6); PG8_BAR; PG8_MMA(1, 1, At, B1); PG8_BAR;
            }
        }
        if constexpr (ALIGN_EPI) { if (wr == 0) PG8_BAR; }
        if constexpr (!Epi::AFTER_DRAIN) { E(acc, cur, wr, wc, fr, fq); S.done(cur); }
        if (!has_next) break;
#pragma unroll
        for (int a = 0; a < 2; ++a)
#pragma unroll
            for (int b = 0; b < 2; ++b)
#pragma unroll
                for (int m = 0; m < 4; ++m)
#pragma unroll
                    for (int n = 0; n < 2; ++n) acc[a][b][m][n] = (f32x4){0.f, 0.f, 0.f, 0.f};
        cur = nxt; cA = nA; cB = nB; ++ui;
        if constexpr (ALIGN_EPI) { if (wr == 1) PG8_BAR; }
    }
    PG8_WAIT_V(0);
    if constexpr (!ALIGN_EPI) { if (wr == 0) PG8_BAR; }
    PG8_BAR;
#undef PG8_SA
#undef PG8_SB
#undef PG8_STAGE
#undef PG8_LDA
#undef PG8_LDB
#undef PG8_MMA
#undef PG8_WAIT_V
#undef PG8_WAIT_L
#undef PG8_BAR
#undef PG8_SCHED
}
}


#define LAS __attribute__((address_space(3)))
#define DI __device__ __forceinline__
typedef unsigned short bf16;
typedef unsigned v4u __attribute__((ext_vector_type(4)));
typedef unsigned v2u __attribute__((ext_vector_type(2)));
typedef float f32x4 __attribute__((ext_vector_type(4)));
#define LDS_WAIT() asm volatile("s_waitcnt lgkmcnt(0)" ::: "memory")

typedef __bf16 bfv2_ __attribute__((ext_vector_type(2)));
typedef float f32v2_ __attribute__((ext_vector_type(2)));
DI unsigned pk2(float lo, float hi) { return __builtin_bit_cast(unsigned, __builtin_convertvector((f32v2_){lo, hi}, bfv2_)); }
DI unsigned f2bf(float f) { unsigned u = __builtin_bit_cast(unsigned, f); return (u + 0x7fffu + ((u >> 16) & 1u)) >> 16; }
DI unsigned pk2s(float lo, float hi) { return f2bf(lo) | (f2bf(hi) << 16); }
DI float bflo(unsigned w) { return __uint_as_float(w << 16); }
DI float bfhi(unsigned w) { return __uint_as_float(w & 0xffff0000u); }
template <int K> DI float shx(float v) {
    if constexpr (K < 32) return __builtin_bit_cast(float, __builtin_amdgcn_ds_swizzle(__builtin_bit_cast(int, v), (K << 10) | 0x1f));
    else return __shfl_xor(v, 32);
}
DI float wave_sum(float v) {
    v += shx<1>(v); v += shx<2>(v); v += shx<4>(v); v += shx<8>(v); v += shx<16>(v); v += shx<32>(v);
    return v;
}
template <int N, int K> DI void wave_sum_step(float (&v)[N]) { float t[N];
#pragma unroll
    for (int i = 0; i < N; ++i) t[i] = shx<K>(v[i]);
#pragma unroll
    for (int i = 0; i < N; ++i) v[i] += t[i]; }
template <int N> DI void wave_sum_n(float (&v)[N]) {
    wave_sum_step<N, 1>(v); wave_sum_step<N, 2>(v); wave_sum_step<N, 4>(v); wave_sum_step<N, 8>(v); wave_sum_step<N, 16>(v); wave_sum_step<N, 32>(v);
}
DI float sigmoidf_(float x) { return __builtin_amdgcn_rcpf(1.0f + __expf(-x)); }
DI float siluf_(float x) { return x * __builtin_amdgcn_rcpf(1.0f + __expf(-x)); }
DI float rsq_(float x) { return __builtin_amdgcn_rsqf(x); }
DI float softplus_(float x) { const float y = __expf(x); return (y < 0.03f) ? y * (1.0f - y * (0.5f - y * (0.33333333f - 0.25f * y))) : __logf(1.0f + y); }

struct Args { const float* in[22]; float* out; unsigned char* ws; int ph_lo, ph_hi; };
struct KIn {
    DI const float* operator[](int k) const { auto kp = __builtin_amdgcn_kernarg_segment_ptr(); asm volatile("" : "+s"(kp));
        return ((const float* const __attribute__((address_space(4)))*)kp)[k]; }
};
struct Frame { LAS unsigned char* lds; int tid, lane, wave, G, bid; KIn in; float* out; unsigned char* ws; };

struct TrDesc { const float* W; const float* scale; bf16* WT; int ldsrc, k0, c0, ldk, n0, koff; };
DI void tr_load(const TrDesc& d, float (&wv_)[32], float (&sc_)[32], int lane) {
#pragma unroll
    for (int i = 0; i < 32; ++i) { const int kk = 2 * i + (lane >> 5); wv_[i] = d.W[(size_t)(d.k0 + kk) * d.ldsrc + d.c0 + (lane & 31)]; sc_[i] = d.scale ? d.scale[d.k0 + kk] : 1.0f; }
}
DI void tr_store(const TrDesc& d, const float (&wv_)[32], const float (&sc_)[32], LAS float* scr, int lane) {
#pragma unroll
    for (int i = 0; i < 32; ++i) { const int kk = 2 * i + (lane >> 5); scr[kk * 33 + (lane & 31)] = wv_[i] * sc_[i]; }
    LDS_WAIT(); asm volatile("" ::: "memory");
    const int c = lane & 7;
#pragma unroll
    for (int j = 0; j < 4; ++j) { const int n = (lane >> 3) + 8 * j; const LAS float* s = scr + (8 * c) * 33 + n;
        v4u o; o.x = pk2(s[0 * 33], s[1 * 33]); o.y = pk2(s[2 * 33], s[3 * 33]); o.z = pk2(s[4 * 33], s[5 * 33]); o.w = pk2(s[6 * 33], s[7 * 33]);
        *(v4u*)(d.WT + (size_t)(d.n0 + n) * d.ldk + d.koff + d.k0 + 8 * c) = o; }
    LDS_WAIT(); asm volatile("" ::: "memory");
}
constexpr int I_IN = 16 * 256, I_P = 16 * 32, I_FI = 16 * 176, I_FO = 44 * 32, I_L = I_IN + 3 * I_P + I_FI + I_FO, WT_CM = 3072;
DI TrDesc tr_decode(Frame& F, int it) {
    const int l = it / I_L; int r = it % I_L; unsigned char* wl = F.ws + WS_W + (size_t)l * W_LAYER; TrDesc d;
    if (r < I_IN) { const int kb = r / 256, nb = r % 256, n0 = 32 * nb, c0 = n0 + (n0 >= 4096 ? 16 : 0);
        d = TrDesc{F.in[5] + (size_t)l * DM * DIN, F.in[4] + l * DM, (bf16*)(wl + W_IN), DIN, 64 * kb, c0, DM, n0, 0}; return d; } r -= I_IN;
    if (r < I_P) { const int kb = r / 32, nb = r % 32; d = TrDesc{F.in[14] + (size_t)l * DM * DM, nullptr, (bf16*)(wl + W_PAB), DM, 64 * kb, 32 * nb, LD_PAB, 32 * nb, 0}; return d; } r -= I_P;
    if (r < I_P) { const int kb = r / 32, nb = r % 32; d = TrDesc{F.in[15] + (size_t)l * DM * DM, nullptr, (bf16*)(wl + W_PAB), DM, 64 * kb, 32 * nb, LD_PAB, 32 * nb, 1024}; return d; } r -= I_P;
    if (r < I_P) { const int kb = r / 32, nb = r % 32; d = TrDesc{F.in[16] + (size_t)l * DM * DM, nullptr, (bf16*)(wl + W_OUT), DM, 64 * kb, 32 * nb, DM, 32 * nb, 0}; return d; } r -= I_P;
    if (r < I_FI) { const int kb = r / 176, nb = r % 176, n0 = 32 * nb, p = n0 / 256, j = n0 % 256, c0 = (j < 128) ? 128 * p + j : DFF + 128 * p + (j - 128);
        d = TrDesc{F.in[19] + (size_t)l * DM * 2 * DFF, F.in[18] + l * DM, (bf16*)(wl + W_FIN), 2 * DFF, 64 * kb, c0, DM, n0, 0}; return d; } r -= I_FI;
    { const int kb = r / 32, nb = r % 32; d = TrDesc{F.in[20] + (size_t)l * DFF * DM, nullptr, (bf16*)(wl + W_FOUT), DM, 64 * kb, 32 * nb, DFF, 32 * nb, 0}; return d; }
}
DI void tr_range(Frame& F, int first, int last, int idx, int cnt) {
    LAS float* scr = (LAS float*)(F.lds + F.wave * 16384);
    const int it0 = first + idx;
    if (it0 < last) {
        float wa[32], sa[32], wb[32], sb[32];
        TrDesc d0 = tr_decode(F, it0); tr_load(d0, wa, sa, F.lane);
#pragma unroll 1
        for (int it = it0; it < last; it += cnt) {
            const bool hn = it + cnt < last;
            TrDesc d1 = d0; if (hn) { d1 = tr_decode(F, it + cnt); tr_load(d1, wb, sb, F.lane); }
            tr_store(d0, wa, sa, scr, F.lane);
            d0 = d1;
#pragma unroll
            for (int i = 0; i < 32; ++i) { wa[i] = wb[i]; sa[i] = sb[i]; }
        }
    }
}
DI void p0_weights(Frame& F) {
    tr_range(F, 0, I_L, F.bid * NWAVES + F.wave, F.G * NWAVES);
    for (int i = F.bid * 512 + F.tid; i < DEPTH * NH * 128 * 128; i += F.G * 512) { const int l = i >> 17, rem = i & 131071, ii = (rem >> 7) & 127, jj = rem & 127;
        ((bf16*)(F.ws + WS_W + (size_t)l * W_LAYER + W_SP))[rem] = (bf16)((jj <= ii) ? f2bf(F.in[12][i]) : 0u); }
}

DI void load_wab_lds(Frame& F, int lab) {
    __syncthreads();
    LAS float* wab = (LAS float*)F.lds;
    { const float* wp = F.in[5] + (size_t)lab * DM * DIN + 4096; const float* nw = F.in[4] + lab * DM; float a_[32], b_[32];
#pragma unroll
      for (int j = 0; j < 32; ++j) { const int i = F.tid + j * (NWAVES * 64), c = i & 15, k = i >> 4; a_[j] = wp[(size_t)k * DIN + c]; b_[j] = nw[k]; }
#pragma unroll
      for (int j = 0; j < 32; ++j) { const int i = F.tid + j * (NWAVES * 64), c = i & 15, k = i >> 4; wab[c * DM + k] = a_[j] * b_[j]; } }
    __syncthreads();
}
constexpr int RB = 4;
DI void rowprep(Frame& F, const f32x4 (&v)[RB][4], const int (&row)[RB], const bool (&ok)[RB], int lab) {
    float s[RB];
#pragma unroll
    for (int k = 0; k < RB; ++k) { s[k] = 0.f;
#pragma unroll
        for (int j = 0; j < 4; ++j) s[k] += (v[k][j].x * v[k][j].x + v[k][j].y * v[k][j].y) + (v[k][j].z * v[k][j].z + v[k][j].w * v[k][j].w); }
    wave_sum_n<RB>(s);
    float rstd[RB];
#pragma unroll
    for (int k = 0; k < RB; ++k) { rstd[k] = rsq_(s[k] * (1.0f / DM) + 1e-6f);
        if (ok[k]) {
            v2u* xb = (v2u*)((bf16*)(F.ws + WS_XB) + (size_t)row[k] * DM) + F.lane;
#pragma unroll
            for (int j = 0; j < 4; ++j) { const f32x4 t = v[k][j] * rstd[k]; v2u o; o.x = pk2(t.x, t.y); o.y = pk2(t.z, t.w); xb[64 * j] = o; } } }
    (void)lab;
}
DI void ab_pass(Frame& F, int lab) {
    const int gw = F.bid * NWAVES + F.wave, NGW = F.G * NWAVES, lane = F.lane;
    const LAS f32x4* wab = (const LAS f32x4*)F.lds;
    const bool b5 = lane & 32, b4 = lane & 16, b3 = lane & 8, b2 = lane & 4;
    const int cq = lane >> 2; const float dtb = F.in[8][lab * NH + (cq & 7)], alg = F.in[7][lab * NH + (cq & 7)];
    asm volatile("s_waitcnt vmcnt(0)" ::: "memory");
    const bf16* xbp = (const bf16*)(F.ws + WS_XB);
    v4u c0, c1, n0 = (v4u){0u, 0u, 0u, 0u}, n1 = n0;
    if (gw < TT) { const v4u* xp = (const v4u*)(xbp + (size_t)gw * DM) + lane * 2; n0 = xp[0]; n1 = xp[1]; }
#pragma unroll 1
    for (int row = gw; row < TT; row += NGW) {
        c0 = n0; c1 = n1;
        if (row + NGW < TT) { const v4u* xp = (const v4u*)(xbp + (size_t)(row + NGW) * DM) + lane * 2; n0 = xp[0]; n1 = xp[1]; }
        float x[16];
#pragma unroll
        for (int e = 0; e < 4; ++e) { x[2 * e] = bflo(c0[e]); x[2 * e + 1] = bfhi(c0[e]); x[8 + 2 * e] = bflo(c1[e]); x[8 + 2 * e + 1] = bfhi(c1[e]); }
        float p[16];
#pragma unroll
        for (int c = 0; c < 16; ++c) { p[c] = 0.f;
#pragma unroll
            for (int j = 0; j < 4; ++j) { const f32x4 w = wab[c * (DM / 4) + lane * 4 + j]; p[c] += (x[4 * j] * w.x + x[4 * j + 1] * w.y) + (x[4 * j + 2] * w.z + x[4 * j + 3] * w.w); }
            if ((c & 3) == 3) asm volatile("" ::: "memory"); }
        float q[8], r4[4], s2[2], t1;
#pragma unroll
        for (int i = 0; i < 8; ++i) { const float snd = b5 ? p[i] : p[8 + i], kp = b5 ? p[8 + i] : p[i]; q[i] = kp + shx<32>(snd); }
#pragma unroll
        for (int i = 0; i < 4; ++i) { const float snd = b4 ? q[i] : q[4 + i], kp = b4 ? q[4 + i] : q[i]; r4[i] = kp + shx<16>(snd); }
#pragma unroll
        for (int i = 0; i < 2; ++i) { const float snd = b3 ? r4[i] : r4[2 + i], kp = b3 ? r4[2 + i] : r4[i]; s2[i] = kp + shx<8>(snd); }
        { const float snd = b2 ? s2[0] : s2[1], kp = b2 ? s2[1] : s2[0]; t1 = kp + shx<4>(snd); }
        t1 += shx<2>(t1); t1 += shx<1>(t1);
        if ((lane & 3) == 0) { float rr_;
            if (cq < 8) { const float xx = t1 + dtb; const float sp = (xx > 20.f) ? xx : softplus_(xx); rr_ = -__expf(alg) * sp; } else rr_ = sigmoidf_(t1);
            ((float*)(F.ws + WS_AB))[(size_t)row * 16 + cq] = rr_; }
    }
}
DI void p0_rows(Frame& F) {
    load_wab_lds(F, 0);
    const int gw = F.bid * NWAVES + F.wave, NGW = F.G * NWAVES;
    for (int base = gw; base < TT; base += NGW * RB) {
        f32x4 v[RB][4]; int row[RB]; bool ok[RB];
#pragma unroll
        for (int k = 0; k < RB; ++k) { const int r = base + k * NGW; ok[k] = r < TT; row[k] = ok[k] ? r : base;
            const float* xr = (row[k] < TP) ? F.in[0] + (size_t)row[k] * DM : F.in[1] + (size_t)(row[k] - TP) * DM;
#pragma unroll
            for (int j = 0; j < 4; ++j) v[k][j] = ((const f32x4*)xr)[F.lane + 64 * j]; }
        rowprep(F, v, row, ok, 0);
    }
    ab_pass(F, 0);
}
DI void rows_residual(Frame& F, const bf16* Y, const float* w, bool x_from_in, bool fin, int lab) {
    if (!fin && lab >= 0) load_wab_lds(F, lab);
    const int gw = F.bid * NWAVES + F.wave, NGW = F.G * NWAVES;
    f32x4 ww[4];
#pragma unroll
    for (int j = 0; j < 4; ++j) ww[j] = ((const f32x4*)w)[F.lane + 64 * j];
    for (int base = gw; base < TT; base += NGW * RB) {
        f32x4 x[RB][4]; int row[RB]; bool ok[RB]; float s[RB];
        {
            f32x4 y[RB][4];
#pragma unroll
            for (int k = 0; k < RB; ++k) { const int r = base + k * NGW; ok[k] = r < TT; row[k] = ok[k] ? r : base;
                const float* xr = x_from_in ? ((row[k] < TP) ? F.in[0] + (size_t)row[k] * DM : F.in[1] + (size_t)(row[k] - TP) * DM) : F.out + (size_t)row[k] * DM;
                s[k] = 0.f;
#pragma unroll
                for (int j = 0; j < 4; ++j) { const v2u yw = ((const v2u*)(Y + (size_t)row[k] * DM))[F.lane + 64 * j]; y[k][j] = (f32x4){bflo(yw.x), bfhi(yw.x), bflo(yw.y), bfhi(yw.y)}; x[k][j] = ((const f32x4*)xr)[F.lane + 64 * j];
                    s[k] += (y[k][j].x * y[k][j].x + y[k][j].y * y[k][j].y) + (y[k][j].z * y[k][j].z + y[k][j].w * y[k][j].w); } }
            wave_sum_n<RB>(s);
#pragma unroll
            for (int k = 0; k < RB; ++k) { const float ry = rsq_(s[k] * (1.0f / DM) + 1e-6f);
#pragma unroll
                for (int j = 0; j < 4; ++j) { x[k][j] = x[k][j] + y[k][j] * ry * ww[j]; if (ok[k]) ((f32x4*)(F.out + (size_t)row[k] * DM))[F.lane + 64 * j] = x[k][j]; } }
        }
        if (!fin) rowprep(F, x, row, ok, lab);
    }
    if (!fin && lab >= 0) ab_pass(F, lab);
}

typedef short s16x4 __attribute__((ext_vector_type(4)));
typedef short bf16x8 __attribute__((ext_vector_type(8)));
typedef float f32x8 __attribute__((ext_vector_type(8)));
typedef float f32x16 __attribute__((ext_vector_type(16)));
typedef float f32x2_ __attribute__((ext_vector_type(2)));
typedef __bf16 bfv8 __attribute__((ext_vector_type(8)));
#define MFMA32(a, b, c) __builtin_amdgcn_mfma_f32_32x32x16_bf16((a), (b), (c), 0, 0, 0)
DI int crow(int reg, int h) { return (reg & 3) + 8 * (reg >> 2) + 4 * h; }
DI bf16x8 pack_lo(const f32x16& x) { const f32x8 v = __builtin_shufflevector(x, x, 0, 1, 2, 3, 4, 5, 6, 7); return __builtin_bit_cast(bf16x8, __builtin_convertvector(v, bfv8)); }
DI bf16x8 pack_hi(const f32x16& x) { const f32x8 v = __builtin_shufflevector(x, x, 8, 9, 10, 11, 12, 13, 14, 15); return __builtin_bit_cast(bf16x8, __builtin_convertvector(v, bfv8)); }
DI f32x16 zero16() { f32x16 z;
#pragma unroll
    for (int i = 0; i < 16; ++i) z[i] = 0.f; return z; }

DI void e1_conv_sample(Frame& F, int l) {
    const int gw = F.bid * NWAVES + F.wave, NGW = F.G * NWAVES, lane = F.lane;
    const bf16* raw = (const bf16*)(F.ws + WS_QKVRAW); bf16* qc = (bf16*)(F.ws + WS_QKVS);
    const float* cw = F.in[6] + (size_t)l * 4 * DCONV; const float* scin = F.in[3];
    for (int it = gw; it < TSM * 3; it += NGW) {
        const int srow = it / 3, part = it - 3 * srow, row = TP + srow, seq = srow / TS_, t = srow % TS_;
        const float* sc = scin + ((size_t)l * NS + seq) * 3 * DCONV;
        float* sco = F.out + O_SCS + ((size_t)l * NS + seq) * 3 * DCONV;
#pragma unroll 1
        for (int s0 = 0; s0 < 8; s0 += 4) {
            unsigned xw[4][4]; f32x2_ sv[4][4], wv[4][4];
#pragma unroll
            for (int i = 0; i < 4; ++i) { const int tt = t - 3 + i, si = (t + i) < 3 ? (t + i) : 2;
#pragma unroll
                for (int sg = 0; sg < 4; ++sg) { const int ch = part * 1024 + (s0 + sg) * 128 + 2 * lane;
                    xw[i][sg] = *(const unsigned*)(raw + (size_t)(tt >= 0 ? row - 3 + i : row) * DCONV + ch);
                    sv[i][sg] = *(const f32x2_*)(sc + (size_t)si * DCONV + ch); wv[i][sg] = *(const f32x2_*)(cw + i * DCONV + ch); } }
            float a0[4], a1[4], ss[4];
#pragma unroll
            for (int sg = 0; sg < 4; ++sg) { a0[sg] = 0.f; a1[sg] = 0.f;
#pragma unroll
                for (int i = 0; i < 4; ++i) { const int tt = t - 3 + i; const float x0 = tt >= 0 ? bflo(xw[i][sg]) : sv[i][sg].x, x1 = tt >= 0 ? bfhi(xw[i][sg]) : sv[i][sg].y; a0[sg] += wv[i][sg].x * x0; a1[sg] += wv[i][sg].y * x1; }
                if (t >= TS_ - 3) { const int ch = part * 1024 + (s0 + sg) * 128 + 2 * lane; *(f32x2_*)(sco + (size_t)(t - (TS_ - 3)) * DCONV + ch) = (f32x2_){bflo(xw[3][sg]), bfhi(xw[3][sg])}; }
                a0[sg] = siluf_(a0[sg]); a1[sg] = siluf_(a1[sg]); ss[sg] = a0[sg] * a0[sg] + a1[sg] * a1[sg]; }
            if (part < 2) wave_sum_n<4>(ss);
#pragma unroll
            for (int sg = 0; sg < 4; ++sg) { const float scl = (part < 2) ? rsq_(ss[sg] + 1e-6f) * (part == 0 ? 0.08838834764831845f : 1.0f) : 1.0f;
                *(unsigned*)(qc + (size_t)srow * DCONV + part * 1024 + (s0 + sg) * 128 + 2 * lane) = pk2(a0[sg] * scl, a1[sg] * scl); }
        }
    }
}

constexpr int PL_KN = 0, PL_QS = 17408, PL_RT = 34816, PL_AF = 71680, PL_AB = 89088, PL_T = 91648, PL_T0T = 100864, PL_G = 103424, PL_RT2 = 103936, PL_RTB = PL_RT2 - PL_RT;
constexpr int KN_LD = 136, RT_LD = 72, AF_LD = 68, AB_LD = 40, T_LD = 72, T0T_LD = 40;
DI bf16x8 lds_frag(const LAS unsigned char* p) { return *(const LAS bf16x8*)p; }
DI bf16x8 lds_frag_perm(const LAS unsigned char* p) {
    const s16x4 lo = *(const LAS s16x4*)p, hi = *(const LAS s16x4*)(p + 16); return __builtin_shufflevector(lo, hi, 0, 1, 2, 3, 4, 5, 6, 7); }
struct PrepIn { unsigned xr[3][11]; float gl, bl; };
DI void prep_load(Frame& F, int unit, PrepIn& pi) {
    const int c = unit & 31, h = (unit >> 5) & 7, b = unit >> 8, row0 = b * SEQ + 64 * c, i0 = 8 * F.wave, cp = F.lane;
    const bf16* raw = (const bf16*)(F.ws + WS_QKVRAW); const float* ab = (const float*)(F.ws + WS_AB);
    pi.gl = ab[(size_t)(row0 + F.lane) * 16 + h]; pi.bl = ab[(size_t)(row0 + F.lane) * 16 + 8 + h];
#pragma unroll
    for (int a = 0; a < 3; ++a) { const int col = a * 1024 + h * HD + 2 * cp;
#pragma unroll
        for (int ii = 0; ii < 11; ++ii) { const int tt = 64 * c + i0 - 3 + ii; pi.xr[a][ii] = *(const unsigned*)(raw + (size_t)(tt >= 0 ? row0 + i0 - 3 + ii : row0) * DCONV + col); } }
}
DI void prep_s1(Frame& F, int l, int unit, PrepIn& pi, int next_unit, int rtoff) {
    const int c = unit & 31, h = (unit >> 5) & 7, b = unit >> 8;
    const int row0 = b * SEQ + 64 * c, w = F.wave, lane = F.lane, r = lane & 31, hh = lane >> 5;
    LAS unsigned char* lds = F.lds;
    unsigned char* rec = F.ws + WS_REC + (size_t)unit * REC_BYTES;
    (void)c; (void)h; (void)b; (void)row0; (void)r; (void)hh; (void)rec; (void)w; (void)lds;
    const float* cw = F.in[6] + (size_t)l * 4 * DCONV;
    const float gl = pi.gl, bl = pi.bl;
    float gc = gl;
#pragma unroll
    for (int o = 1; o < 64; o <<= 1) { const float t = __shfl_up(gc, o); if (lane >= o) gc += t; }
    const float glast = __shfl(gc, 63);
    if (w == 0) { ((LAS float*)(lds + PL_G))[lane] = gc; ((LAS float*)(lds + PL_G))[64 + lane] = bl; if (lane == 0) ((float*)(F.ws + WS_EG))[unit] = __expf(glast); }
    {
        const int cp = lane, i0 = 8 * w;
#pragma unroll
        for (int a = 0; a < 3; ++a) {
            const int col = a * 1024 + h * HD + 2 * cp; float x[11][2];
#pragma unroll
            for (int ii = 0; ii < 11; ++ii) { const int tt = 64 * c + i0 - 3 + ii; x[ii][0] = tt >= 0 ? bflo(pi.xr[a][ii]) : 0.f; x[ii][1] = tt >= 0 ? bfhi(pi.xr[a][ii]) : 0.f; }
            float wv[4][2];
#pragma unroll
            for (int i = 0; i < 4; ++i) { const f32x2_ t2 = *(const f32x2_*)(cw + i * DCONV + col); wv[i][0] = t2.x; wv[i][1] = t2.y; }
            if (c == 31 && w == 7) {
                float* sco = F.out + O_SCP + ((size_t)l * NB + b) * 3 * DCONV + col;
#pragma unroll
                for (int j = 0; j < 3; ++j) { sco[(size_t)j * DCONV] = x[8 + j][0]; sco[(size_t)j * DCONV + 1] = x[8 + j][1]; }
            }
            float y[8][2];
#pragma unroll
            for (int rr = 0; rr < 8; ++rr)
#pragma unroll
                for (int e = 0; e < 2; ++e) { float acc = 0.f;
#pragma unroll
                    for (int i = 0; i < 4; ++i) acc += wv[i][e] * x[rr + i][e];
                    y[rr][e] = siluf_(acc); }
            if (a < 2) {
                float ssq[8];
#pragma unroll
                for (int rr = 0; rr < 8; ++rr) ssq[rr] = y[rr][0] * y[rr][0] + y[rr][1] * y[rr][1];
                wave_sum_n<8>(ssq);
#pragma unroll
                for (int rr = 0; rr < 8; ++rr) { const float sc = rsq_(ssq[rr] + 1e-6f) * (a == 0 ? 0.08838834764831845f : 1.0f); y[rr][0] *= sc; y[rr][1] *= sc; }
            }
            if (a == 0) {
#pragma unroll
                for (int rr = 0; rr < 8; ++rr) { const int i = i0 + rr; const float ei = __expf(__shfl(gc, i0 + rr));
                    *(LAS unsigned*)(lds + PL_QS + (i * KN_LD + 2 * cp) * 2) = pk2(y[rr][0], y[rr][1]);
                    const int dk = 2 * cp, fidx = (((i >> 5) * 4 + (dk >> 5)) * 2 + ((dk >> 4) & 1)), ln = (i & 31) + 32 * ((dk >> 2) & 1), el = ((dk >> 3) & 1) * 4 + (dk & 3);
                    *(unsigned*)(rec + R_QG + fidx * 1024 + ln * 16 + el * 2) = pk2(y[rr][0] * ei, y[rr][1] * ei); }
            } else {
                unsigned r0[4], r1[4];
#pragma unroll
                for (int rr = 0; rr < 8; ++rr) { const float bi_ = __shfl(bl, i0 + rr); const float f = (a == 1) ? bi_ * __expf(__shfl(gc, i0 + rr)) : bi_; const unsigned p0 = f2bf(y[rr][0] * f), p1 = f2bf(y[rr][1] * f);
                    if (rr & 1) { r0[rr >> 1] |= p0 << 16; r1[rr >> 1] |= p1 << 16; } else { r0[rr >> 1] = p0; r1[rr >> 1] = p1; } }
                const int n0 = (a == 1 ? 128 : 0) + 2 * cp;
                *(LAS v4u*)(lds + PL_RT + rtoff + (n0 * RT_LD + i0) * 2) = (v4u){r0[0], r0[1], r0[2], r0[3]};
                *(LAS v4u*)(lds + PL_RT + rtoff + ((n0 + 1) * RT_LD + i0) * 2) = (v4u){r1[0], r1[1], r1[2], r1[3]};
                if (a == 1) {
#pragma unroll
                    for (int rr = 0; rr < 8; ++rr) *(LAS unsigned*)(lds + PL_KN + ((i0 + rr) * KN_LD + 2 * cp) * 2) = pk2(y[rr][0], y[rr][1]);
                    float d[8];
#pragma unroll
                    for (int rr = 0; rr < 8; ++rr) d[rr] = __expf(glast - __shfl(gc, i0 + rr));
#pragma unroll
                    for (int e = 0; e < 2; ++e) { const int dk = 2 * cp + e; const int fidx = ((dk >> 5) * 2 + (i0 >> 5)) * 2 + ((i0 >> 4) & 1), el = ((i0 >> 3) & 1) * 4;
                        *(v2u*)(rec + R_KGT + fidx * 1024 + ((dk & 31)) * 16 + el * 2) = (v2u){pk2(y[0][e] * d[0], y[1][e] * d[1]), pk2(y[2][e] * d[2], y[3][e] * d[3])};
                        *(v2u*)(rec + R_KGT + fidx * 1024 + ((dk & 31) + 32) * 16 + el * 2) = (v2u){pk2(y[4][e] * d[4], y[5][e] * d[5]), pk2(y[6][e] * d[6], y[7][e] * d[7])}; }
                }
            }
        }
    }
    if (next_unit >= 0) prep_load(F, next_unit, pi);
}
DI void prep_s2(Frame& F, int unit) {
    const int c = unit & 31, h = (unit >> 5) & 7, b = unit >> 8;
    const int row0 = b * SEQ + 64 * c, w = F.wave, lane = F.lane, r = lane & 31, hh = lane >> 5;
    LAS unsigned char* lds = F.lds;
    unsigned char* rec = F.ws + WS_REC + (size_t)unit * REC_BYTES;
    (void)c; (void)h; (void)b; (void)row0; (void)r; (void)hh; (void)rec; (void)w; (void)lds;
    if (w < 6) {
        int ln_ = lane; asm volatile("" : "+v"(ln_)); const int r = ln_ & 31, hh = ln_ >> 5;
        const int ta = (w == 1 || w == 2 || w == 5) ? 1 : 0, tb = (w == 2 || w == 4 || w == 5) ? 1 : 0; const bool iskk = w < 3;
        f32x16 acc = zero16();
        const LAS unsigned char* ap = lds + PL_KN + ((32 * ta + r) * KN_LD + 8 * hh) * 2;
        const LAS unsigned char* bp = lds + (iskk ? PL_KN : PL_QS) + ((32 * tb + r) * KN_LD + 8 * hh) * 2;
#pragma unroll
        for (int ks = 0; ks < 8; ++ks) acc = MFMA32(lds_frag(ap + ks * 32), lds_frag(bp + ks * 32), acc);
        const LAS float* gcl = (const LAS float*)(lds + PL_G); const LAS float* bel = gcl + 64;
        const int cidx = 32 * tb + r; const float gcc = gcl[cidx];
        if (iskk) {
#pragma unroll
            for (int reg = 0; reg < 16; ++reg) { const int i = 32 * ta + crow(reg, hh); const float v = (i > cidx) ? bel[i] * acc[reg] * __expf(gcl[i] - gcc) : 0.f;
                *(LAS float*)(lds + PL_AF + (i * AF_LD + cidx) * 4) = v;
                if (w == 1) *(LAS unsigned short*)(lds + PL_AB + ((i - 32) * AB_LD + cidx) * 2) = (unsigned short)f2bf(v); }
        } else {
#pragma unroll
            for (int reg = 0; reg < 16; ++reg) { const int j = 32 * ta + crow(reg, hh); acc[reg] = (cidx >= j) ? acc[reg] * __expf(gcc - gcl[j]) : 0.f; }
            unsigned char* dst = rec + R_QK + (size_t)((tb * 2 + ta) * 2) * 1024 + ln_ * 16;
            *(bf16x8*)dst = pack_lo(acc); *(bf16x8*)(dst + 1024) = pack_hi(acc);
        }
    } else if (w == 6) {
        const bf16x8 z = {0, 0, 0, 0, 0, 0, 0, 0}; unsigned char* dst = rec + R_QK + (size_t)((0 * 2 + 1) * 2) * 1024 + lane * 16; *(bf16x8*)dst = z; *(bf16x8*)(dst + 1024) = z;
    }
}
DI void prep_s34(Frame& F) {
    const int w = 0, lane = F.lane, r = lane & 31, hh = lane >> 5; LAS unsigned char* lds = F.lds;
    if (w == 0) {
        const int bsel = hh, cc = r; float T[32];
        const LAS float* arow = (const LAS float*)(lds + PL_AF) + (32 * bsel) * AF_LD + 32 * bsel;
#pragma unroll
        for (int i = 0; i < 32; ++i) { float acc = (i == cc) ? 1.f : 0.f;
#pragma unroll
            for (int q = 0; q < (i + 3) / 4; ++q) { const f32x4 a4 = *(const LAS f32x4*)(arow + i * AF_LD + 4 * q);
#pragma unroll
                for (int e = 0; e < 4; ++e) if (4 * q + e < i) acc -= a4[e] * T[4 * q + e]; }
            T[i] = acc; if ((i & 1) == 1) asm volatile("" ::: "memory"); }
#pragma unroll
        for (int i = 0; i < 32; ++i) { *(LAS unsigned short*)(lds + PL_T + ((32 * bsel + i) * T_LD + 32 * bsel + cc) * 2) = (unsigned short)f2bf(T[i]);
            if (bsel == 0) *(LAS unsigned short*)(lds + PL_T + (i * T_LD + 32 + cc) * 2) = 0; }
        if (bsel == 0) {
#pragma unroll
            for (int q = 0; q < 4; ++q) *(LAS v4u*)(lds + PL_T0T + (cc * T0T_LD + 8 * q) * 2) = (v4u){pk2s(T[8 * q], T[8 * q + 1]), pk2s(T[8 * q + 2], T[8 * q + 3]), pk2s(T[8 * q + 4], T[8 * q + 5]), pk2s(T[8 * q + 6], T[8 * q + 7])}; }
    }
    if (w == 0) {
        int ln_ = lane; asm volatile("" : "+v"(ln_)); const int r = ln_ & 31, hh = ln_ >> 5;
        f32x16 P = zero16();
#pragma unroll
        for (int s2 = 0; s2 < 2; ++s2) P = MFMA32(lds_frag(lds + PL_AB + (r * AB_LD + 16 * s2 + 8 * hh) * 2), lds_frag(lds + PL_T0T + (r * T0T_LD + 16 * s2 + 8 * hh) * 2), P);
        f32x16 X = zero16();
        X = MFMA32(lds_frag_perm(lds + PL_T + ((32 + r) * T_LD + 32 + 4 * hh) * 2), pack_lo(P), X);
        X = MFMA32(lds_frag_perm(lds + PL_T + ((32 + r) * T_LD + 32 + 16 + 4 * hh) * 2), pack_hi(P), X);
#pragma unroll
        for (int reg = 0; reg < 16; ++reg) *(LAS unsigned short*)(lds + PL_T + ((32 + crow(reg, hh)) * T_LD + r) * 2) = (unsigned short)f2bf(-X[reg]);
    }
}
DI void prep_s5(Frame& F, int unit, int rtoff) {
    const int c = unit & 31, h = (unit >> 5) & 7, b = unit >> 8;
    const int row0 = b * SEQ + 64 * c, w = F.wave, lane = F.lane, r = lane & 31, hh = lane >> 5;
    LAS unsigned char* lds = F.lds;
    unsigned char* rec = F.ws + WS_REC + (size_t)unit * REC_BYTES;
    (void)c; (void)h; (void)b; (void)row0; (void)r; (void)hh; (void)rec; (void)w; (void)lds;
    int ln5_ = lane; asm volatile("" : "+v"(ln5_));
    if (w < 4) {
        const int r = ln5_ & 31, hh = ln5_ >> 5;
#pragma unroll
        for (int mt = 0; mt < 2; ++mt) { f32x16 acc = zero16();
#pragma unroll
            for (int ks = 0; ks < 4; ++ks) if (ks < 2 * (mt + 1)) acc = MFMA32(lds_frag(lds + PL_T + ((32 * mt + r) * T_LD + 16 * ks + 8 * hh) * 2), lds_frag(lds + PL_RT + rtoff + ((32 * w + r) * RT_LD + 16 * ks + 8 * hh) * 2), acc);
            unsigned char* dst = rec + R_U + (size_t)((w * 2 + mt) * 64 + lane) * 32;
            *(bf16x8*)dst = pack_lo(acc); *(bf16x8*)(dst + 16) = pack_hi(acc); }
    } else {
        const int kt = w - 4, r = ln5_ & 31, hh = ln5_ >> 5;
#pragma unroll
        for (int it = 0; it < 2; ++it) { f32x16 acc = zero16();
#pragma unroll
            for (int ks = 0; ks < 4; ++ks) if (ks < 2 * (it + 1)) acc = MFMA32(lds_frag(lds + PL_RT + rtoff + ((128 + 32 * kt + r) * RT_LD + 16 * ks + 8 * hh) * 2), lds_frag(lds + PL_T + ((32 * it + r) * T_LD + 16 * ks + 8 * hh) * 2), acc);
#pragma unroll
            for (int reg = 0; reg < 16; ++reg) acc[reg] = -acc[reg];
            unsigned char* dst = rec + R_WN + (size_t)(((it * 4 + kt) * 2) * 64 + lane) * 16;
            *(bf16x8*)dst = pack_lo(acc); *(bf16x8*)(dst + 1024) = pack_hi(acc); }
    }
}
DI void prep_phase(Frame& F, int l) {
    constexpr int NU = NB * NH * 32;
    if (F.bid < NU) {
        PrepIn pi; const int u0 = F.bid;
        prep_load(F, u0, pi);
        prep_s1(F, l, u0, pi, (u0 + F.G < NU) ? u0 + F.G : -1, 0); __syncthreads();
        prep_s2(F, u0); __syncthreads();
#pragma unroll 1
        for (int k = 0; ; ++k) { const int u = u0 + k * F.G, un = u + F.G; const bool has_next = un < NU;
            if (F.wave == 0) prep_s34(F);
            if (has_next) prep_s1(F, l, un, pi, (un + F.G < NU) ? un + F.G : -1, ((k + 1) & 1) * PL_RTB);
            __syncthreads();
            prep_s5(F, u, (k & 1) * PL_RTB);
            if (has_next) prep_s2(F, un);
            __syncthreads();
            if (!has_next) break;
        }
    }
    e1_conv_sample(F, l);
}

constexpr int SC_OB = 2 * REC_FRAG_BYTES, OB_LD = 136, OB_BYTES = 64 * OB_LD * 2, SC_DNW = SC_OB + 2 * OB_BYTES;
DI void scan_finish(Frame& F, int l, int b, int h, int c, const LAS unsigned char* ob, const v4u (&zr)[4], int t4) {
    const int row = t4 >> 2, seg = t4 & 3;
    const LAS float* dnw = (const LAS float*)(F.lds + SC_DNW) + seg * 32;
    v4u ov[4]; float ss = 0.f;
#pragma unroll
    for (int q = 0; q < 4; ++q) { ov[q] = *(const LAS v4u*)(ob + row * (OB_LD * 2) + seg * 64 + q * 16);
#pragma unroll
        for (int e = 0; e < 4; ++e) { const float a = bflo(ov[q][e]), bb = bfhi(ov[q][e]); ss += a * a + bb * bb; } }
    ss += __shfl_xor(ss, 1); ss += __shfl_xor(ss, 2);
    const float rs = rsq_(ss * (1.0f / HD) + 1e-6f);
    bf16* dst = (bf16*)(F.ws + WS_OAB) + (size_t)(b * SEQ + 64 * c + row) * LD_OAB + h * HD + seg * 32;
#pragma unroll
    for (int q = 0; q < 4; ++q) { v4u o4;
#pragma unroll
        for (int e = 0; e < 4; ++e) { const float a = bflo(ov[q][e]) * rs * dnw[q * 8 + 2 * e] * siluf_(bflo(zr[q][e])), bb = bfhi(ov[q][e]) * rs * dnw[q * 8 + 2 * e + 1] * siluf_(bfhi(zr[q][e])); o4[e] = pk2(a, bb); }
        *(v4u*)(dst + q * 8) = o4; }
}
DI void scan_unit(Frame& F, int l, int bh) {
    const int w = F.wave, lane = F.lane, r = lane & 31, hh = lane >> 5, b = bh >> 3, h = bh & 7;
    LAS unsigned char* lds = F.lds;
    const unsigned char* rec0 = F.ws + WS_REC + (size_t)bh * 32 * REC_BYTES;
    const float egl = ((const float*)(F.ws + WS_EG))[bh * 32 + (lane & 31)];
    const int t4 = F.tid - 256;
    const bf16* zbase = (const bf16*)(F.ws + WS_Z) + (size_t)(b * SEQ + (t4 >> 2)) * DM + h * HD + (t4 & 3) * 32;
    f32x16 S[4];
#pragma unroll
    for (int k = 0; k < 4; ++k) S[k] = zero16();
#define SCAN_DMA(cidx, buf) do { const unsigned char* src_ = rec0 + (size_t)(cidx) * REC_BYTES; _Pragma("unroll") for (int it_ = 0; it_ < 7; ++it_) \
        __builtin_amdgcn_global_load_lds((const unsigned*)(src_ + (it_ * 8 + w) * 1024 + lane * 16), (LAS unsigned*)(lds + (buf) * REC_FRAG_BYTES + (it_ * 8 + w) * 1024), 16, 0, 0); } while (0)
    SCAN_DMA(0, 0);
    v4u pf[4];
    if (F.tid < HD) ((LAS float*)(lds + SC_DNW))[F.tid] = F.in[9][l * HD + F.tid];
    if (w < 4) {
#pragma unroll
        for (int mt = 0; mt < 2; ++mt) { const unsigned char* up = rec0 + R_U + (size_t)((w * 2 + mt) * 64 + lane) * 32; pf[mt * 2] = *(const v4u*)up; pf[mt * 2 + 1] = *(const v4u*)(up + 16); }
    }
#pragma unroll 1
    for (int c = 0; c < 32; ++c) {
        asm volatile("s_waitcnt vmcnt(0)" ::: "memory");
        __syncthreads();
        if (w < 4) {
            f32x16 vn[2];
#pragma unroll
            for (int mt = 0; mt < 2; ++mt)
#pragma unroll
                for (int q = 0; q < 2; ++q)
#pragma unroll
                    for (int e = 0; e < 4; ++e) { vn[mt][q * 8 + 2 * e] = bflo(pf[mt * 2 + q][e]); vn[mt][q * 8 + 2 * e + 1] = bfhi(pf[mt * 2 + q][e]); }
            __builtin_amdgcn_sched_barrier(0);
            if (c + 1 < 32) {
                SCAN_DMA(c + 1, (c + 1) & 1);
#pragma unroll
                for (int mt = 0; mt < 2; ++mt) { const unsigned char* up = rec0 + (size_t)(c + 1) * REC_BYTES + R_U + (size_t)((w * 2 + mt) * 64 + lane) * 32; pf[mt * 2] = *(const v4u*)up; pf[mt * 2 + 1] = *(const v4u*)(up + 16); }
            }
            __builtin_amdgcn_sched_barrier(0);
            const LAS unsigned char* fb = lds + (c & 1) * REC_FRAG_BYTES + lane * 16;
            const float eg = __shfl(egl, c);
            f32x16 o[2]; o[0] = zero16(); o[1] = zero16();
            bf16x8 f0[4], f1[4], f2[4];
#define SB_ __builtin_amdgcn_sched_barrier(0)
#define LDW(kt, s2, f) do { f[0] = lds_frag(fb + R_WN + ((0 * 4 + (kt)) * 2 + (s2)) * 1024); f[1] = lds_frag(fb + R_WN + ((1 * 4 + (kt)) * 2 + (s2)) * 1024); \
                f[2] = lds_frag(fb + R_QG + ((0 * 4 + (kt)) * 2 + (s2)) * 1024); f[3] = lds_frag(fb + R_QG + ((1 * 4 + (kt)) * 2 + (s2)) * 1024); SB_; } while (0)
#define MMW(kt, s2, f) do { const bf16x8 sb_ = (s2) ? pack_hi(S[kt]) : pack_lo(S[kt]); \
                vn[0] = MFMA32(f[0], sb_, vn[0]); vn[1] = MFMA32(f[1], sb_, vn[1]); o[0] = MFMA32(f[2], sb_, o[0]); o[1] = MFMA32(f[3], sb_, o[1]); SB_; } while (0)
#define LDQK(s2, f) do { f[0] = lds_frag(fb + R_QK + ((0 * 2 + 0) * 2 + (s2)) * 1024); f[1] = lds_frag(fb + R_QK + ((1 * 2 + 0) * 2 + (s2)) * 1024); f[2] = lds_frag(fb + R_QK + ((1 * 2 + 1) * 2 + (s2)) * 1024); SB_; } while (0)
#define LDK(it, s2, f) do { _Pragma("unroll") for (int kt_ = 0; kt_ < 4; ++kt_) f[kt_] = lds_frag(fb + R_KGT + ((kt_ * 2 + (it)) * 2 + (s2)) * 1024); SB_; } while (0)
#define MMK(f, vb_) do { _Pragma("unroll") for (int kt_ = 0; kt_ < 4; ++kt_) S[kt_] = MFMA32(f[kt_], vb_, S[kt_]); SB_; } while (0)
            LDW(0, 0, f0); LDW(0, 1, f1);
            LDW(1, 0, f2); MMW(0, 0, f0);
            LDW(1, 1, f0); MMW(0, 1, f1);
            LDW(2, 0, f1); MMW(1, 0, f2);
            LDW(2, 1, f2); MMW(1, 1, f0);
            LDW(3, 0, f0); MMW(2, 0, f1);
            LDW(3, 1, f1); MMW(2, 1, f2);
            LDQK(0, f2);   MMW(3, 0, f0);
            LDQK(1, f0);   MMW(3, 1, f1);
#pragma unroll
            for (int kt = 0; kt < 4; ++kt)
#pragma unroll
                for (int reg = 0; reg < 16; ++reg) S[kt][reg] *= eg;
            const bf16x8 v00 = pack_lo(vn[0]), v01 = pack_hi(vn[0]), v10 = pack_lo(vn[1]), v11 = pack_hi(vn[1]);
            LDK(0, 0, f1);
            o[0] = MFMA32(f2[0], v00, o[0]); o[1] = MFMA32(f2[1], v00, o[1]); o[1] = MFMA32(f2[2], v10, o[1]); SB_;
            LDK(0, 1, f2);
            o[0] = MFMA32(f0[0], v01, o[0]); o[1] = MFMA32(f0[1], v01, o[1]); o[1] = MFMA32(f0[2], v11, o[1]); SB_;
            LDK(1, 0, f0); MMK(f1, v00);
            LDK(1, 1, f1); MMK(f2, v01);
            MMK(f0, v10); MMK(f1, v11);
#undef LDW
#undef MMW
#undef LDQK
#undef LDK
#undef MMK
#undef SB_
            LAS unsigned char* ob = lds + SC_OB + (c & 1) * OB_BYTES + (32 * w + r) * 2;
#pragma unroll
            for (int mt = 0; mt < 2; ++mt)
#pragma unroll
                for (int reg = 0; reg < 16; reg += 2) { const unsigned pw = pk2(o[mt][reg], o[mt][reg + 1]); *(LAS unsigned short*)(ob + (32 * mt + crow(reg, hh)) * (OB_LD * 2)) = (unsigned short)pw; *(LAS unsigned short*)(ob + (32 * mt + crow(reg + 1, hh)) * (OB_LD * 2)) = (unsigned short)(pw >> 16); }
        } else {
            if (c + 1 < 32) SCAN_DMA(c + 1, (c + 1) & 1);
            if (c > 0) scan_finish(F, l, b, h, c - 1, lds + SC_OB + ((c - 1) & 1) * OB_BYTES, pf, t4);
#pragma unroll
            for (int q = 0; q < 4; ++q) pf[q] = *(const v4u*)(zbase + (size_t)(64 * c) * DM + q * 8);
        }
    }
#undef SCAN_DMA
    asm volatile("s_waitcnt vmcnt(0)" ::: "memory");
    __syncthreads();
    if (w < 4) {
        float* so = F.out + O_SDP + (((size_t)l * NB + b) * NH + h) * HD * HD + 32 * w + r;
#pragma unroll
        for (int kt = 0; kt < 4; ++kt)
#pragma unroll
            for (int reg = 0; reg < 16; ++reg) so[(size_t)(32 * kt + crow(reg, hh)) * HD] = S[kt][reg];
    } else scan_finish(F, l, b, h, 31, lds + SC_OB + (31 & 1) * OB_BYTES, pf, t4);
    __syncthreads();
}

DI void d_units_sample4(Frame& F, int l, int ubase) {
    const int w = F.wave, lane = F.lane, unit = ubase + (w >> 1), half = w & 1, seq = unit >> 3, h = unit & 7;
    const bf16* qc = (const bf16*)(F.ws + WS_QKVS); const float* ab = (const float*)(F.ws + WS_AB);
    const int row0 = TP + seq * TS_, dv = half * 64 + lane;
    LAS unsigned char* wl = F.lds + w * 8192;
    LAS unsigned char* ol = F.lds + 65536 + (w >> 1) * 4096;
    { const int t = lane >> 3, part = (lane >> 2) & 1, ch = lane & 3; const v4u* src = (const v4u*)(qc + (size_t)(row0 - TP + t) * DCONV + part * 1024 + h * HD + ch * 32);
      LAS f32x4* dst = (LAS f32x4*)(wl + t * 1024 + part * 512 + ch * 128);
#pragma unroll
      for (int q = 0; q < 4; ++q) { const v4u a = src[q]; dst[2 * q] = (f32x4){bflo(a.x), bfhi(a.x), bflo(a.y), bfhi(a.y)}; dst[2 * q + 1] = (f32x4){bflo(a.z), bfhi(a.z), bflo(a.w), bfhi(a.w)}; } }
    float gt[8], bt[8], vv[8];
#pragma unroll
    for (int t = 0; t < 8; ++t) { gt[t] = ab[(size_t)(row0 + t) * 16 + h]; bt[t] = ab[(size_t)(row0 + t) * 16 + 8 + h]; vv[t] = pg8::bf2f(qc[(size_t)(row0 - TP + t) * DCONV + 2048 + h * HD + dv]); }
    {
        f32x2_ S[64];
        { const float* s0 = F.in[2] + (((size_t)l * NS + seq) * NH + h) * HD * HD + dv;
#pragma unroll
          for (int k = 0; k < 64; ++k) { S[k].x = s0[(size_t)(2 * k) * HD]; S[k].y = s0[(size_t)(2 * k + 1) * HD]; } }
#pragma unroll 1
        for (int t = 0; t < TS_; ++t) {
            float g = gt[0], beta = bt[0], vt = vv[0];
#pragma unroll
            for (int i = 1; i < 8; ++i) { if (t == i) { g = gt[i]; beta = bt[i]; vt = vv[i]; } }
            const float e = __expf(g);
            const LAS f32x4* kp = (const LAS f32x4*)(wl + t * 1024 + 512); const LAS f32x4* qp = (const LAS f32x4*)(wl + t * 1024);
            f32x2_ ks2 = (f32x2_){0.f, 0.f};
#pragma unroll
            for (int c = 0; c < 32; ++c) { const f32x4 kw = kp[c]; ks2 = ks2 + (f32x2_){kw.x, kw.y} * S[2 * c]; ks2 = ks2 + (f32x2_){kw.z, kw.w} * S[2 * c + 1];
                if ((c & 7) == 7) asm volatile("" ::: "memory"); }
            const float dlt = beta * (vt - e * (ks2.x + ks2.y));
            f32x2_ o2 = (f32x2_){0.f, 0.f};
#pragma unroll
            for (int c = 0; c < 32; ++c) { const f32x4 kw = kp[c], qw = qp[c];
                S[2 * c] = S[2 * c] * e + (f32x2_){kw.x, kw.y} * dlt; o2 = o2 + (f32x2_){qw.x, qw.y} * S[2 * c];
                S[2 * c + 1] = S[2 * c + 1] * e + (f32x2_){kw.z, kw.w} * dlt; o2 = o2 + (f32x2_){qw.z, qw.w} * S[2 * c + 1];
                if ((c & 3) == 3) asm volatile("" ::: "memory"); }
            *(LAS float*)(ol + (t * 128 + dv) * 4) = o2.x + o2.y;
        }
        float* so = F.out + O_SDS + (((size_t)l * NS + seq) * NH + h) * HD * HD + dv;
#pragma unroll
        for (int k = 0; k < 64; ++k) { so[(size_t)(2 * k) * HD] = S[k].x; so[(size_t)(2 * k + 1) * HD] = S[k].y; }
    }
    __syncthreads();
    const bf16* z = (const bf16*)(F.ws + WS_Z); bf16* oab = (bf16*)(F.ws + WS_OAB); const float* dnw = F.in[9] + l * HD;
    const float w0 = dnw[2 * lane], w1 = dnw[2 * lane + 1];
    f32x2_ ov[4]; float ss[4]; unsigned zw[4];
#pragma unroll
    for (int k = 0; k < 4; ++k) { const int t = 4 * half + k; ov[k] = *(const LAS f32x2_*)(ol + (t * 128 + 2 * lane) * 4); ss[k] = ov[k].x * ov[k].x + ov[k].y * ov[k].y; zw[k] = *(const unsigned*)(z + (size_t)(row0 + t) * DM + h * HD + 2 * lane); }
    wave_sum_n<4>(ss);
#pragma unroll
    for (int k = 0; k < 4; ++k) { const int t = 4 * half + k; const float rs = rsq_(ss[k] * (1.0f / HD) + 1e-6f);
        *(unsigned*)(oab + (size_t)(row0 + t) * LD_OAB + h * HD + 2 * lane) = pk2(ov[k].x * rs * w0 * siluf_(bflo(zw[k])), ov[k].y * rs * w1 * siluf_(bfhi(zw[k]))); }
    __syncthreads();
}
constexpr int CL_ST = 0, CL_VT = 1024, VT_LD = 136, CL_MX = 1024 + 128 * 136 * 2, MX_LD = 132;
DI void cmlp_unit(Frame& F, int l, int ck) {
    const int w = F.wave, lane = F.lane, row0 = 128 * ck;
    LAS unsigned char* lds = F.lds;
    const bf16* uv = (const bf16*)(F.ws + WS_UV); bf16* oab = (bf16*)(F.ws + WS_OAB);
    const float* lw = F.in[10] + l * DB; const float* lb = F.in[11] + l * DB; const float* bsp = F.in[13] + (size_t)l * NH * 128;
    const bf16* wsp = (const bf16*)(F.ws + WS_W + (size_t)l * W_LAYER + W_SP);
    const bool lastck = (ck & 15) == 15;
#pragma unroll 1
    for (int rb = 0; rb < 4; ++rb) {
        f32x4 v[4][4]; float sm[4], sq[4];
#pragma unroll
        for (int k = 0; k < 4; ++k) { const int row = row0 + 16 * w + 4 * rb + k; sm[k] = 0.f;
#pragma unroll
            for (int j = 0; j < 4; ++j) { const v2u u = *((const v2u*)(uv + (size_t)row * 2048 + 1024) + lane + 64 * j); v[k][j] = (f32x4){bflo(u.x), bfhi(u.x), bflo(u.y), bfhi(u.y)}; sm[k] += (v[k][j].x + v[k][j].y) + (v[k][j].z + v[k][j].w); } }
        wave_sum_n<4>(sm);
#pragma unroll
        for (int k = 0; k < 4; ++k) { const float mean = sm[k] * (1.0f / DB); sm[k] = mean; sq[k] = 0.f;
#pragma unroll
            for (int j = 0; j < 4; ++j) { v[k][j] = v[k][j] - mean; sq[k] += (v[k][j].x * v[k][j].x + v[k][j].y * v[k][j].y) + (v[k][j].z * v[k][j].z + v[k][j].w * v[k][j].w); } }
        wave_sum_n<4>(sq);
#pragma unroll
        for (int k = 0; k < 4; ++k) { const int i = 16 * w + 4 * rb + k; const float rstd = rsq_(sq[k] * (1.0f / DB) + 1e-5f);
            if (lane == 0) { ((LAS float*)(lds + CL_ST))[2 * i] = sm[k]; ((LAS float*)(lds + CL_ST))[2 * i + 1] = rstd; }
            if (lastck) { float* cvo = F.out + O_CVP + (((size_t)l * NB + (ck >> 4)) * 128 + i) * DB;
#pragma unroll
                for (int j = 0; j < 4; ++j) { const f32x4 ww = ((const f32x4*)lw)[lane + 64 * j], bb = ((const f32x4*)lb)[lane + 64 * j]; ((f32x4*)cvo)[lane + 64 * j] = v[k][j] * rstd * ww + bb; } } }
    }
    __syncthreads();
    const int r = lane & 31, hh = lane >> 5, nt = w & 3, mta = (w >> 2) ? 1 : 0, mtb = 3 - mta;
    const int erow = F.tid >> 2, eseg = F.tid & 3;
    unsigned va[8], vb[8];
#define CMLP_VLOAD(g_) do { const int ch_ = (g_) * 128 + 2 * lane; _Pragma("unroll") for (int pr = 0; pr < 8; ++pr) { const int j_ = 16 * w + 2 * pr; \
        va[pr] = *(const unsigned*)(uv + (size_t)(row0 + j_) * 2048 + 1024 + ch_); vb[pr] = *(const unsigned*)(uv + (size_t)(row0 + j_ + 1) * 2048 + 1024 + ch_); } } while (0)
    CMLP_VLOAD(0);
#pragma unroll 1
    for (int g = 0; g < 8; ++g) {
        const bf16* wg = wsp + (size_t)g * 128 * 128;
        bf16x8 wa[4], wb[8];
#pragma unroll
        for (int ks = 0; ks < 4; ++ks) wa[ks] = *(const bf16x8*)(wg + (size_t)(32 * mta + r) * 128 + 16 * ks + 8 * hh);
#pragma unroll
        for (int ks = 0; ks < 8; ++ks) wb[ks] = *(const bf16x8*)(wg + (size_t)(32 * mtb + r) * 128 + 16 * ks + 8 * hh);
        const size_t eoff = (size_t)(row0 + erow) * 2048 + g * 128 + eseg * 32;
        v4u uu[4];
#pragma unroll
        for (int q = 0; q < 4; ++q) uu[q] = *(const v4u*)(uv + eoff + q * 8);
        { const int ch = g * 128 + 2 * lane; const float w0 = lw[ch], w1 = lw[ch + 1], b0 = lb[ch], b1 = lb[ch + 1];
#pragma unroll
          for (int pr = 0; pr < 8; ++pr) { const int j = 16 * w + 2 * pr; const unsigned ua = va[pr], ub = vb[pr];
            const f32x4 st = *(const LAS f32x4*)(lds + CL_ST + j * 8);
            const float a0 = (bflo(ua) - st.x) * st.y * w0 + b0, a1 = (bfhi(ua) - st.x) * st.y * w1 + b1, c0 = (bflo(ub) - st.z) * st.w * w0 + b0, c1 = (bfhi(ub) - st.z) * st.w * w1 + b1;
            *(LAS unsigned*)(lds + CL_VT + ((2 * lane) * VT_LD + j) * 2) = pk2(a0, c0);
            *(LAS unsigned*)(lds + CL_VT + ((2 * lane + 1) * VT_LD + j) * 2) = pk2(a1, c1); } }
        if (g + 1 < 8) CMLP_VLOAD(g + 1);
        __syncthreads();
        f32x16 acc[2]; acc[0] = zero16(); acc[1] = zero16();
#pragma unroll
        for (int ks = 0; ks < 8; ++ks) {
            const bf16x8 bfr = lds_frag(lds + CL_VT + ((32 * nt + r) * VT_LD + 16 * ks + 8 * hh) * 2);
            if (ks < 4) acc[0] = MFMA32(wa[ks], bfr, acc[0]);
            acc[1] = MFMA32(wb[ks], bfr, acc[1]);
        }
#pragma unroll
        for (int t2 = 0; t2 < 2; ++t2) { const int mt = t2 ? mtb : mta;
#pragma unroll
            for (int reg = 0; reg < 16; ++reg) { const int i = 32 * mt + crow(reg, hh); *(LAS float*)(lds + CL_MX + (i * MX_LD + 32 * nt + r) * 4) = acc[t2][reg] + bsp[g * 128 + i]; } }
        __syncthreads();
#pragma unroll
        for (int q = 0; q < 4; ++q) { const f32x4 m0 = *(const LAS f32x4*)(lds + CL_MX + (erow * MX_LD + eseg * 32 + q * 8) * 4), m1 = *(const LAS f32x4*)(lds + CL_MX + (erow * MX_LD + eseg * 32 + q * 8 + 4) * 4);
            v4u o; o.x = pk2(bflo(uu[q].x) * m0.x, bfhi(uu[q].x) * m0.y); o.y = pk2(bflo(uu[q].y) * m0.z, bfhi(uu[q].y) * m0.w); o.z = pk2(bflo(uu[q].z) * m1.x, bfhi(uu[q].z) * m1.y); o.w = pk2(bflo(uu[q].w) * m1.z, bfhi(uu[q].w) * m1.w);
            *(v4u*)(oab + (size_t)(row0 + erow) * LD_OAB + 1024 + g * 128 + eseg * 32 + q * 8) = o; }
    }
#undef CMLP_VLOAD
    __syncthreads();
}
DI void cmlp_sample_unit(Frame& F, int l, int n, int jq) {
    const int lane = F.lane, row0 = TP + n * TS_;
    const bf16* uv = (const bf16*)(F.ws + WS_UV); bf16* oab = (bf16*)(F.ws + WS_OAB);
    const float* lw = F.in[10] + l * DB; const float* lb = F.in[11] + l * DB; const float* bsp = F.in[13] + (size_t)l * NH * 128; const float* wsp = F.in[12] + (size_t)l * NH * 128 * 128;
    v2u raw[8][4];
#pragma unroll
    for (int t = 0; t < 8; ++t)
#pragma unroll
        for (int j = 0; j < 4; ++j) raw[t][j] = *((const v2u*)(uv + (size_t)(row0 + t) * 2048 + 1024) + lane + 64 * j);
    v2u uu[8];
#pragma unroll
    for (int t = 0; t < 8; ++t) uu[t] = *(const v2u*)(uv + (size_t)(row0 + t) * 2048 + 4 * lane + 256 * jq);
    const int g = 2 * jq + (lane >> 5);
    float wm[8][8];
#pragma unroll
    for (int i = 0; i < 8; ++i)
#pragma unroll
        for (int jj = 0; jj <= i; ++jj) wm[i][jj] = wsp[((size_t)g * 128 + i) * 128 + jj];
    float sm[8], sq[8];
#pragma unroll
    for (int t = 0; t < 8; ++t) { sm[t] = 0.f;
#pragma unroll
        for (int j = 0; j < 4; ++j) sm[t] += (bflo(raw[t][j].x) + bfhi(raw[t][j].x)) + (bflo(raw[t][j].y) + bfhi(raw[t][j].y)); }
    wave_sum_n<8>(sm);
#pragma unroll
    for (int t = 0; t < 8; ++t) { const float mean = sm[t] * (1.0f / DB); sm[t] = mean; sq[t] = 0.f;
#pragma unroll
        for (int j = 0; j < 4; ++j) { const float a = bflo(raw[t][j].x) - mean, b2 = bfhi(raw[t][j].x) - mean, c = bflo(raw[t][j].y) - mean, d = bfhi(raw[t][j].y) - mean; sq[t] += (a * a + b2 * b2) + (c * c + d * d); } }
    wave_sum_n<8>(sq);
    const f32x4 ww = ((const f32x4*)lw)[lane + 64 * jq], bb = ((const f32x4*)lb)[lane + 64 * jq];
    f32x4 vn[8];
#pragma unroll
    for (int t = 0; t < 8; ++t) { const float rstd = rsq_(sq[t] * (1.0f / DB) + 1e-5f), mean = sm[t];
        f32x4 v;
        if (jq == 0) v = (f32x4){bflo(raw[t][0].x), bfhi(raw[t][0].x), bflo(raw[t][0].y), bfhi(raw[t][0].y)};
        else if (jq == 1) v = (f32x4){bflo(raw[t][1].x), bfhi(raw[t][1].x), bflo(raw[t][1].y), bfhi(raw[t][1].y)};
        else if (jq == 2) v = (f32x4){bflo(raw[t][2].x), bfhi(raw[t][2].x), bflo(raw[t][2].y), bfhi(raw[t][2].y)};
        else v = (f32x4){bflo(raw[t][3].x), bfhi(raw[t][3].x), bflo(raw[t][3].y), bfhi(raw[t][3].y)};
        vn[t] = (v - mean) * rstd * ww + bb;
        ((f32x4*)(F.out + O_CVS + (((size_t)l * NS + n) * TS_ + t) * DB))[lane + 64 * jq] = vn[t]; }
#pragma unroll
    for (int i = 0; i < 8; ++i) { f32x4 m = (f32x4){0.f, 0.f, 0.f, 0.f};
#pragma unroll
        for (int jj = 0; jj <= i; ++jj) m = m + vn[jj] * wm[i][jj];
        m = m + bsp[g * 128 + i];
        v2u o; o.x = pk2(bflo(uu[i].x) * m.x, bfhi(uu[i].x) * m.y); o.y = pk2(bflo(uu[i].y) * m.z, bfhi(uu[i].y) * m.w);
        *(v2u*)(oab + (size_t)(row0 + i) * LD_OAB + 1024 + 4 * lane + 256 * jq) = o; }
}
DI void d_phase(Frame& F, int l) {
    constexpr int NU = NS * NH, U_SB = 512;
    if (F.bid < NB * NH) { scan_unit(F, l, F.bid); return; }
    if (F.bid < NB * NH + 128) { const int cb = F.bid - NB * NH; cmlp_unit(F, l, cb);
        for (int ub = U_SB + 4 * cb; ub < NU; ub += 4 * 128) d_units_sample4(F, l, ub);
        if (l == 0) tr_range(F, I_L, I_L + WT_CM, cb * NWAVES + F.wave, 128 * NWAVES);
        return; }
    const int sb = F.bid - NB * NH - 128, nsb = F.G - NB * NH - 128;
    for (int ub = 4 * sb; ub < U_SB; ub += 4 * nsb) d_units_sample4(F, l, ub);
    const int gw = sb * NWAVES + F.wave, NGW = nsb * NWAVES;
    for (int u = gw; u < NS * 4; u += NGW) cmlp_sample_unit(F, l, u >> 2, u & 3);
    if (l == 0) { __syncthreads(); tr_range(F, I_L + WT_CM, 2 * I_L, gw, NGW); }
}
typedef float f32x4_ __attribute__((ext_vector_type(4)));
DI void tail_gemm(Frame& F, int kind, const bf16* A, const bf16* Bt, int K, int lda, int ldb) {
    const int w = F.wave, lane = F.lane, t = F.bid, idx = t >> 4, sub = t & 15;
    const int row0 = TP + 256 * (idx >> 2) + 64 * (sub >> 2), col0 = 256 * (idx & 3) + 64 * (sub & 3);
    const int kw = K >> 3, nks = kw >> 5, l15 = lane & 15, lq = lane >> 4;
    const bf16* ap = A + (size_t)(row0 + l15) * lda + w * kw + 8 * lq;
    const bf16* bp = Bt + (size_t)(col0 + l15) * ldb + w * kw + 8 * lq;
    f32x4_ acc[4][4];
#pragma unroll
    for (int mi = 0; mi < 4; ++mi)
#pragma unroll
        for (int ni = 0; ni < 4; ++ni) acc[mi][ni] = (f32x4_){0.f, 0.f, 0.f, 0.f};
#pragma unroll 1
    for (int k0 = 0; k0 < nks; k0 += 4) {
        bf16x8 fa[4][4], fb[4][4];
#pragma unroll
        for (int kk = 0; kk < 4; ++kk) { const int ko = (k0 + kk < nks) ? 32 * (k0 + kk) : 0;
#pragma unroll
            for (int q = 0; q < 4; ++q) { fa[kk][q] = *(const bf16x8*)(ap + (size_t)(16 * q) * lda + ko); fb[kk][q] = *(const bf16x8*)(bp + (size_t)(16 * q) * ldb + ko); } }
#pragma unroll
        for (int kk = 0; kk < 4; ++kk) { if (k0 + kk < nks) {
#pragma unroll
            for (int mi = 0; mi < 4; ++mi)
#pragma unroll
                for (int ni = 0; ni < 4; ++ni) acc[mi][ni] = __builtin_amdgcn_mfma_f32_16x16x32_bf16(fa[kk][mi], fb[kk][ni], acc[mi][ni], 0, 0, 0); } }
    }
    LAS float* pl = (LAS float*)(F.lds + w * 16384);
#pragma unroll
    for (int mi = 0; mi < 4; ++mi)
#pragma unroll
        for (int ni = 0; ni < 4; ++ni)
#pragma unroll
            for (int rg = 0; rg < 4; ++rg) pl[(16 * mi + 4 * lq + rg) * 64 + 16 * ni + l15] = acc[mi][ni][rg];
    __syncthreads();
    const int er = F.tid >> 3, ec = (F.tid & 7) * 8;
    f32x4_ s0[2], s1[2]; s0[0] = s0[1] = s1[0] = s1[1] = (f32x4_){0.f, 0.f, 0.f, 0.f};
#pragma unroll
    for (int ww = 0; ww < 8; ++ww) { const LAS f32x4_* p = (const LAS f32x4_*)(F.lds + ww * 16384 + (er * 64 + ec) * 4);
        if (ww < 4) { s0[0] = s0[0] + p[0]; s0[1] = s0[1] + p[1]; } else { s1[0] = s1[0] + p[0]; s1[1] = s1[1] + p[1]; } }
    float o[8];
    if (kind == 1) {
        const bf16* gt = (const bf16*)(F.ws + WS_GT) + (size_t)(row0 + er) * 2048 + col0 + ec;
        const v4u gaw = *(const v4u*)gt, gbw = *(const v4u*)(gt + 1024);
#pragma unroll
        for (int e = 0; e < 4; ++e) { const float a0 = bflo(gaw[e]), a1 = bfhi(gaw[e]), b0 = bflo(gbw[e]), b1 = bfhi(gbw[e]);
            o[2 * e] = sigmoidf_(a0) * s0[e >> 1][(2 * e) & 3] + sigmoidf_(b0) * s1[e >> 1][(2 * e) & 3];
            o[2 * e + 1] = sigmoidf_(a1) * s0[e >> 1][(2 * e + 1) & 3] + sigmoidf_(b1) * s1[e >> 1][(2 * e + 1) & 3]; }
    } else {
#pragma unroll
        for (int e = 0; e < 8; ++e) o[e] = s0[e >> 2][e & 3] + s1[e >> 2][e & 3];
    }
    bf16* dst = (bf16*)(F.ws + (kind == 1 ? WS_MERGED : WS_Y)) + (size_t)(row0 + er) * DM + col0 + ec;
    *(v4u*)dst = (v4u){pk2(o[0], o[1]), pk2(o[2], o[3]), pk2(o[4], o[5]), pk2(o[6], o[7])};
    __syncthreads();
}

#define XB_TMO      128
#define XB_XCNT(j)  (256  + 64 * (j))
#define XB_XSUB(j)  (1280 + 64 * (j))
#define XB_XGEN(j)  (2304 + 64 * (j))
#define XB_TOP      3328
#define XB_TOPGEN   3392
#define XCD_BAR_WORDS 3456
#define XB_SPIN_CAP (1u << 22)
__device__ __forceinline__ unsigned xb_ld(unsigned* p)              { return __hip_atomic_load(p, __ATOMIC_RELAXED, __HIP_MEMORY_SCOPE_AGENT); }
__device__ __forceinline__ unsigned xb_add(unsigned* p, unsigned v) { return __hip_atomic_fetch_add(p, v, __ATOMIC_RELAXED, __HIP_MEMORY_SCOPE_AGENT); }
__device__ __forceinline__ unsigned xb_xcc_id() { return (unsigned)__builtin_amdgcn_s_getreg((3 << 11) | 20) & 0xFu; }
#define XB_SPIN(cond, bar) do { unsigned _sp = 0; while (cond) { __builtin_amdgcn_s_sleep(1); \
    if ((++_sp & 255u) == 0u) { if (xb_ld(&(bar)[XB_TMO])) break; if (_sp > XB_SPIN_CAP) { atomicAdd(&(bar)[XB_TMO], 1u); break; } } } } while (0)
struct XcdBarrier { unsigned* bar; unsigned x; volatile LAS unsigned* st; };
__device__ __forceinline__ XcdBarrier xcd_barrier_post(unsigned* bar, volatile LAS unsigned* st) {
    XcdBarrier b; b.bar = bar; b.x = xb_xcc_id(); b.st = st;
    if (threadIdx.x == 0) (void)xb_add(&bar[XB_XCNT(b.x)], 1u);
    return b;
}
__device__ __forceinline__ void xcd_barrier_complete(unsigned* bar, unsigned x, unsigned& nloc, unsigned& nx) {
    const unsigned G = gridDim.x * gridDim.y * gridDim.z;
    unsigned sum, cnt, mine, sp = 0u;
    for (;;) {
        sum = 0u; cnt = 0u; mine = 0u;
#pragma unroll 1
        for (unsigned j = 0; j < 16; ++j) { const unsigned c = xb_ld(&bar[XB_XCNT(j)]); sum += c; cnt += (c > 0u) ? 1u : 0u; mine = (j == x) ? c : mine; }
        if (sum == G) break;
        __builtin_amdgcn_s_sleep(1);
        if ((++sp & 255u) == 0u) { if (xb_ld(&bar[XB_TMO])) break; if (sp > XB_SPIN_CAP) { atomicAdd(&bar[XB_TMO], 1u); break; } }
    }
    nloc = mine > 0u ? mine : 1u; nx = cnt > 0u ? cnt : 1u;
}
__device__ __forceinline__ void xcd_barrier(const XcdBarrier& b) {
    asm volatile("s_waitcnt vmcnt(0)" ::: "memory");
    __syncthreads();
    if (threadIdx.x == 0) {
        unsigned* bar = b.bar; asm volatile("" : "+s"(bar));
        __builtin_amdgcn_s_waitcnt(0);
        unsigned nloc = b.st[0], nx = b.st[1];
        if (nloc == 0u) { xcd_barrier_complete(bar, b.x, nloc, nx); b.st[0] = nloc; b.st[1] = nx; }
        const unsigned old = xb_add(&bar[XB_XSUB(b.x)], 1u);
        const unsigned gen = old / nloc;
        if (old + 1u == (gen + 1u) * nloc) {
            __builtin_amdgcn_fence(__ATOMIC_RELEASE, "agent");
            asm volatile("s_waitcnt vmcnt(0)" ::: "memory");
            const unsigned og = xb_add(&bar[XB_TOP], 1u);
            const unsigned tg = og / nx;
            if (og + 1u == (tg + 1u) * nx) xb_add(&bar[XB_TOPGEN], 1u);
            else XB_SPIN(xb_ld(&bar[XB_TOPGEN]) == tg, bar);
            __builtin_amdgcn_fence(__ATOMIC_ACQUIRE, "agent");
            xb_add(&bar[XB_XGEN(b.x)], 1u);
            asm volatile("s_waitcnt vmcnt(0)" ::: "memory");
        } else {
            XB_SPIN(xb_ld(&bar[XB_XGEN(b.x)]) == gen, bar);
            __builtin_amdgcn_fence(__ATOMIC_ACQUIRE, "agent");
            asm volatile("s_waitcnt vmcnt(0)" ::: "memory");
        }
    }
    __syncthreads();
}

constexpr int PH_PER_LAYER = 9, N_PHASES = 1 + DEPTH * PH_PER_LAYER;
__global__ void __launch_bounds__(NWAVES * 64, 2) mega_fwd(Args args) {
    extern __shared__ __attribute__((aligned(16))) unsigned char lds_raw[];
    Frame F; F.lds = (LAS unsigned char*)lds_raw; F.tid = threadIdx.x; F.lane = F.tid & 63; F.wave = __builtin_amdgcn_readfirstlane(F.tid >> 6);
    F.G = gridDim.x; F.bid = blockIdx.x; F.out = args.out; F.ws = args.ws;
#if MK_ONE_LAUNCH
    if (threadIdx.x < 16) ((LAS unsigned*)(F.lds + LDS_BYTES - 64))[threadIdx.x] = 0u;
    __syncthreads();
    const XcdBarrier xbar = xcd_barrier_post((unsigned*)(args.ws + WS_CTL) + 4096, (volatile LAS unsigned*)(F.lds + LDS_BYTES - 64));
#define SEAM(k) do { if ((k) + 1 < hi) xcd_barrier(xbar); } while (0)
#else
#define SEAM(k) do { } while (0)
#endif
#ifndef PH_MASK
#define PH_MASK 0x7ff
#endif
#define EN(j) ((PH_MASK >> (j)) & 1)
    int lo = args.ph_lo; const int hi = args.ph_hi;
    unsigned char* ws = args.ws;
    if (lo == 0) {
        { __attribute__((address_space(1))) unsigned char* w_ = (__attribute__((address_space(1))) unsigned char*)args.ws; asm volatile("" : "+s"(w_)); F.ws = (unsigned char*)w_; }
        if (EN(10)) { p0_weights(F); p0_rows(F); }
#if MK_ONE_LAUNCH
        if (hi > 1) cg::this_grid().sync();
#endif
        lo = 1;
    }
#pragma unroll 1
    for (int p = lo; p < hi; ++p) {
        { __attribute__((address_space(1))) unsigned char* w_ = (__attribute__((address_space(1))) unsigned char*)args.ws; __attribute__((address_space(1))) float* o_ = (__attribute__((address_space(1))) float*)args.out;
          int t_ = threadIdx.x; asm volatile("" : "+s"(w_), "+s"(o_), "+v"(t_)); ws = (unsigned char*)w_; F.ws = (unsigned char*)w_; F.out = (float*)o_;
          F.tid = t_; F.lane = t_ & 63; F.wave = __builtin_amdgcn_readfirstlane(t_ >> 6); }
        {
            const int l = (p - 1) / PH_PER_LAYER, j = (p - 1) % PH_PER_LAYER;
            int gk = -1;
#define REOPQ() do { __attribute__((address_space(1))) unsigned char* w__ = (__attribute__((address_space(1))) unsigned char*)args.ws; asm volatile("" : "+s"(w__)); F.ws = (unsigned char*)w__; ws = (unsigned char*)w__; } while (0)
            if (j == 0 || j == 3 || j == 4 || j == 6 || j == 7) gk = j;
            else if (j == 1) { REOPQ(); if (EN(1)) prep_phase(F, l); }
            else if (j == 2) { REOPQ(); if (EN(2)) d_phase(F, l); }
            else if (EN(5)) { REOPQ(); const bool r1 = (j == 5); rows_residual(F, (const bf16*)(ws + WS_Y), (r1 ? F.in[17] : F.in[21]) + l * DM, r1 && l == 0, !r1 && l == DEPTH - 1, r1 ? -1 : l + 1); }
            if (EN(0) && gk >= 0) {
                REOPQ(); unsigned char* wl = ws + WS_W + (size_t)l * W_LAYER;
                pg8::Gemm g; pg8::EpiAny E; E.mid_t = -1; E.ws = ws;
                if (gk == 0)      { g = pg8::Gemm{(const bf16*)(ws + WS_XB), (const bf16*)(wl + W_IN), TT, 8192, DM, DM, DM}; E.kind = 0; }
                else if (gk == 3) { g = pg8::Gemm{(const bf16*)(ws + WS_OAB), (const bf16*)(wl + W_PAB), TT, DM, 2048, LD_OAB, LD_PAB}; E.kind = 1; E.mid_t = 16; }
                else if (gk == 4) { g = pg8::Gemm{(const bf16*)(ws + WS_MERGED), (const bf16*)(wl + W_OUT), TT, DM, DM, DM, DM}; E.kind = 2; }
                else if (gk == 6) { g = pg8::Gemm{(const bf16*)(ws + WS_XB), (const bf16*)(wl + W_FIN), TT, 2 * DFF, DM, DM, DM}; E.kind = 3; }
                else              { g = pg8::Gemm{(const bf16*)(ws + WS_H), (const bf16*)(wl + W_FOUT), TT, DM, DFF, DFF, DFF}; E.kind = 2; }
                const bool n1k = (g.N == DM);
                if (n1k) g.M = TP;
                pg8::StaticOrder S; S.init(g.M, g.N, F.G, F.bid); S.pmaj = n1k ? 1 : 0;
                pg8::gemm_phase<pg8::EpiAny, pg8::StaticOrder, true, true>(F.lds, g, S, E);
                if (n1k) tail_gemm(F, E.kind, g.A, g.Bt, g.K, g.lda, g.ldb);
            }
        }
        SEAM(p);
    }
#undef SEAM
}

extern "C" void kernel_launch(void* const* d_in, const int* in_sizes, int n_in, void* d_out, int out_size, void* d_ws, size_t ws_size, hipStream_t stream) {
    static int grid = 0;
    if (grid == 0) {
        if (n_in != 22 || (size_t)out_size != O_END || ws_size < WS_END) { fprintf(stderr, "kernel_launch: unexpected shapes: n_in %d out %d (want %zu) ws %zu (need %zu)\n", n_in, out_size, (size_t)O_END, ws_size, (size_t)WS_END); grid = -1; return; }
        int dev = 0, cus = 0, per_cu = 0;
        if (hipGetDevice(&dev) != hipSuccess || hipDeviceGetAttribute(&cus, hipDeviceAttributeMultiprocessorCount, dev) != hipSuccess) { grid = -1; return; }
        if (hipFuncSetAttribute((const void*)mega_fwd, hipFuncAttributeMaxDynamicSharedMemorySize, LDS_BYTES) != hipSuccess) { fprintf(stderr, "kernel_launch: hipFuncSetAttribute failed\n"); grid = -1; return; }
        if (hipOccupancyMaxActiveBlocksPerMultiprocessor(&per_cu, (const void*)mega_fwd, NWAVES * 64, LDS_BYTES) != hipSuccess || per_cu < 1) { fprintf(stderr, "kernel_launch: occupancy query says %d\n", per_cu); per_cu = 1; }
        (void)hipGetLastError();
        grid = cus;
        if (grid != 256) { fprintf(stderr, "kernel_launch: this kernel is laid out for a 256-CU device (got %d)\n", grid); grid = -1; return; }
    }
    if (grid < 0) return;
    Args a{};
    for (int i = 0; i < 22; ++i) a.in[i] = (const float*)d_in[i];
    a.out = (float*)d_out; a.ws = (unsigned char*)d_ws;
#if MK_ONE_LAUNCH
    if (hipMemsetAsync((char*)d_ws + WS_CTL, 0, 64 * 1024, stream) != hipSuccess) { fprintf(stderr, "kernel_launch: memset failed\n"); return; }
    a.ph_lo = 0; a.ph_hi = N_PHASES;
    void* kargs[] = {&a};
    hipError_t e = hipLaunchCooperativeKernel((void*)mega_fwd, dim3(grid), dim3(NWAVES * 64), kargs, LDS_BYTES, stream);
    if (e != hipSuccess) fprintf(stderr, "cooperative launch failed: %s (grid %d)\n", hipGetErrorString(e), grid);
#else
    for (int p = 0; p < N_PHASES; ++p) { a.ph_lo = p; a.ph_hi = p + 1; hipLaunchKernelGGL(mega_fwd, dim3(grid), dim3(NWAVES * 64), LDS_BYTES, stream, a); }
#endif
}
```

```cpp
#include <hip/hip_runtime.h>
#include <hip/hip_cooperative_groups.h>
#include <cstdio>
#include <cstdint>
namespace cg = cooperative_groups;

#ifndef MK_ONE_LAUNCH
#define MK_ONE_LAUNCH 1
#endif

constexpr int NWAVES = 8;
constexpr int DM = 1024, NB = 8, SEQ = 2048, DEPTH = 2, NS = 128, TS_ = 8, NH = 8, HD = 128, DCONV = 3072, DB = 1024, DFF = 2816, DIN = 8208;
constexpr int TP = NB * SEQ, TSM = NS * TS_, TT = TP + TSM;
constexpr size_t O_YP = 0, O_YS = (size_t)TP * DM, O_SDP = O_YS + (size_t)TSM * DM, O_SCP = O_SDP + (size_t)DEPTH * NB * NH * HD * HD,
                 O_CVP = O_SCP + (size_t)DEPTH * NB * 3 * DCONV, O_SDS = O_CVP + (size_t)DEPTH * NB * 128 * DB, O_SCS = O_SDS + (size_t)DEPTH * NS * NH * HD * HD,
                 O_CVS = O_SCS + (size_t)DEPTH * NS * 3 * DCONV, O_END = O_CVS + (size_t)DEPTH * NS * TS_ * DB;
constexpr size_t MiB = 1u << 20;
constexpr int LD_OAB = 2112, LD_PAB = 2112;
constexpr size_t WS_CTL = 0, WS_AB = 1 * MiB, WS_RSTD = 3 * MiB, WS_EG = 3 * MiB + 512 * 1024, WS_W = 4 * MiB, W_LAYER = 41 * MiB;
constexpr size_t W_IN = 0, W_PAB = 17 * MiB, W_OUT = 21 * MiB + 256 * 1024, W_FIN = 23 * MiB + 512 * 1024, W_FOUT = 35 * MiB + 256 * 1024, W_SP = 40 * MiB + 768 * 1024;
constexpr size_t WS_A = 86 * MiB, WS_C = 188 * MiB, WS_D = 222 * MiB, WS_E = 290 * MiB, WS_REC = 358 * MiB, WS_QKVS = 502 * MiB, WS_END = 508 * MiB;
constexpr size_t WS_QKVRAW = WS_A, WS_ORAW = WS_A, WS_H = WS_A, WS_Z = WS_C, WS_MERGED = WS_C, WS_UV = WS_D, WS_Y = WS_D, WS_GT = WS_E,
                 WS_XB = WS_REC, WS_OAB = WS_A;
constexpr int REC_BYTES = 73728, R_WN = 0, R_QG = 16384, R_KGT = 32768, R_QK = 49152, R_U = 57344, REC_FRAG_BYTES = 57344;
constexpr int LDS_BYTES = 163840;

namespace pg8 {
#define PG8_LAS __attribute__((address_space(3)))
typedef unsigned short bf16_t;
typedef short bf16x8 __attribute__((ext_vector_type(8)));
typedef float f32x4 __attribute__((ext_vector_type(4)));
typedef unsigned u32x4 __attribute__((ext_vector_type(4)));
constexpr int BM = 256, BK = 64, HALF = 128, HTB = HALF * BK * 2, STAGE_BYTES = 8 * HTB, NXCD = 8, WGM = 8;

__host__ __device__ __forceinline__ int lds_byte(int r, int c) { const int st = (r >> 4) * 2 + (c >> 5), rr = r & 15, cc = c & 31, ob = rr * 64 + cc * 2; return st * 1024 + (ob ^ (((ob >> 9) & 1) << 5)); }
__host__ __device__ __forceinline__ void stage_rc(int b, int& R, int& C) { const int st = b / 1024, sb = b % 1024, swz = sb ^ (((sb >> 9) & 1) << 5); R = (st >> 1) * 16 + swz / 64; C = (st & 1) * 32 + (swz % 64) / 2; }
__host__ __device__ __forceinline__ int perm32(int rho) { const int n = rho >> 4, i = rho & 15; return 8 * (i >> 2) + 4 * n + (i & 3); }

struct Unit { int pm, pn, qm; };
struct Gemm { const bf16_t* A; const bf16_t* Bt; int M, N, K, lda, ldb; };

struct StaticOrder {
    int nM, nN, nwg, G, c, pmaj;
    __host__ __device__ void init(int M, int N, int G_, int c_) { nM = M / BM; nN = N / BM; nwg = nM * nN; G = G_; c = c_; pmaj = 0; }
    __host__ __device__ bool next(int i, Unit& u) const {
        if (pmaj) {
            if (i > 0 || c >= 256) return false; const int x = c & 7, slot = c >> 3; u.pm = (slot >> 2) * 8 + x; u.pn = slot & 3; u.qm = 15; return true; }
        long L = (long)i * G + c; u.qm = 15;
        { const int full = nwg / G, rem = nwg - full * G;
          if (rem > 0 && i == full) {
              if (4 * rem <= G) { if (c >= 4 * rem) return false; L = (long)full * G + (c >> 2); u.qm = 1 << (c & 3); }
              else if (2 * rem <= G) { if (c >= 2 * rem) return false; L = (long)full * G + (c >> 1); u.qm = (c & 1) ? 12 : 3; } } }
        if (L >= nwg) return false;
        int wgid = (int)L; { const int q = nwg / NXCD, r = nwg % NXCD, xcd = wgid % NXCD, off = wgid / NXCD; wgid = (xcd < r ? xcd * (q + 1) : r * (q + 1) + (xcd - r) * q) + off; }
        const int nig = WGM * nN, gid = wgid / nig, fm = gid * WGM, gsz = (nM - fm) < WGM ? (nM - fm) : WGM;
        u.pm = fm + ((wgid % nig) % gsz); u.pn = (wgid % nig) / gsz; return true;
    }
    __device__ __forceinline__ void a_ready(const Unit&) const {}
    __device__ __forceinline__ void done(const Unit&) const {}
};

__device__ __forceinline__ unsigned cvt_pk_bf16(float lo, float hi) { unsigned r; asm volatile("v_cvt_pk_bf16_f32 %0, %1, %2" : "=v"(r) : "v"(lo), "v"(hi)); return r; }
typedef float f32x2 __attribute__((ext_vector_type(2)));
__device__ __forceinline__ f32x2 gelu_pk(f32x2 v) {
    const f32x2 av = __builtin_elementwise_abs(v), d = av * 0.2316418882f + 1.0f;
    f32x2 t; t.x = __builtin_amdgcn_rcpf(d.x); t.y = __builtin_amdgcn_rcpf(d.y);
    f32x2 q = t * 0.5307027145f + (-0.7265760135f); q = q * t + 0.7107068705f; q = q * t + (-0.142248368f); q = q * t + 0.127414796f; q = q * t;
    const f32x2 s = (v * v) * (-0.72134752044f);
    f32x2 e; e.x = __builtin_amdgcn_exp2f(s.x); e.y = __builtin_amdgcn_exp2f(s.y);
    const f32x2 m = v * (q * e), r = v - m;
    f32x2 o; o.x = v.x < 0.f ? m.x : r.x; o.y = v.y < 0.f ? m.y : r.y; return o;
}
__device__ __forceinline__ float sigm(float x) { return __builtin_amdgcn_rcpf(1.0f + __expf(-x)); }
__device__ __forceinline__ float bf2f(unsigned short u) { return __uint_as_float((unsigned)u << 16); }


struct EpiProj {
    static constexpr bool PERM = true, AFTER_DRAIN = false; static constexpr int MID_T = 0;
    unsigned char* ws;
    __device__ __forceinline__ void mid(f32x4 (&acc)[2][2][4][2], const Unit& u, int wr, int wc, int fr, int fq) const {}
    __device__ __forceinline__ void operator()(const f32x4 (&acc)[2][2][4][2], const Unit& u, int wr, int wc, int fr, int fq) const {
        const int row0 = u.pm * BM + wr * 64 + fr; const int pn = u.pn;
        bf16_t* base; int ld, colt; bool act = false;
        if (pn < 12) { base = (bf16_t*)(ws + WS_QKVRAW); ld = 3072; colt = pn * BM; }
        else if (pn < 16) { base = (bf16_t*)(ws + WS_Z); ld = 1024; colt = (pn - 12) * BM; }
        else if (pn < 24) { base = (bf16_t*)(ws + WS_UV); ld = 2048; colt = (pn - 16) * BM; act = true; }
        else { base = (bf16_t*)(ws + WS_GT); ld = 2048; colt = (pn - 24) * BM; }
        const int col0 = colt + wc * 32 + 8 * fq;
#pragma unroll
        for (int ai = 0; ai < 2; ++ai)
#pragma unroll
            for (int m = 0; m < 4; ++m) { if (!((u.qm >> (2 * ai)) & 3)) continue; const int row = row0 + ai * HALF + m * 16; bf16_t* rowp = base + (size_t)row * ld + col0;
#pragma unroll
                for (int bj = 0; bj < 2; ++bj) { if (!((u.qm >> (2 * ai + bj)) & 1)) continue; f32x4 v0 = acc[ai][bj][m][0], v1 = acc[ai][bj][m][1];
                    if (act) { f32x2 a = gelu_pk((f32x2){v0[0], v0[1]}), b = gelu_pk((f32x2){v0[2], v0[3]}), c = gelu_pk((f32x2){v1[0], v1[1]}), d = gelu_pk((f32x2){v1[2], v1[3]});
                        v0 = (f32x4){a.x, a.y, b.x, b.y}; v1 = (f32x4){c.x, c.y, d.x, d.y}; }
                    u32x4 w; w.x = cvt_pk_bf16(v0[0], v0[1]); w.y = cvt_pk_bf16(v0[2], v0[3]); w.z = cvt_pk_bf16(v1[0], v1[1]); w.w = cvt_pk_bf16(v1[2], v1[3]);
                    *(u32x4*)(rowp + bj * HALF) = w; } }
    }
};
struct EpiMerge {
    static constexpr bool PERM = true, AFTER_DRAIN = false; static constexpr int MID_T = 16;
    unsigned char* ws;
    __device__ __forceinline__ void mid(f32x4 (&acc)[2][2][4][2], const Unit& u, int wr, int wc, int fr, int fq) const {
        int row0 = u.pm * BM + wr * 64 + fr, col0 = u.pn * BM + wc * 32 + 8 * fq;
        asm volatile("" : "+v"(row0), "+v"(col0));
        const bf16_t* GT = (const bf16_t*)(ws + WS_GT);
#pragma unroll
        for (int ai = 0; ai < 2; ++ai) {
            u32x4 ga[4][2], gb[4][2];
#pragma unroll
            for (int m = 0; m < 4; ++m) { const bf16_t* gp = GT + (size_t)(row0 + ai * HALF + m * 16) * 2048 + col0;
#pragma unroll
                for (int bj = 0; bj < 2; ++bj) { ga[m][bj] = *(const u32x4*)(gp + bj * HALF); gb[m][bj] = *(const u32x4*)(gp + 1024 + bj * HALF); } }
#pragma unroll
            for (int m = 0; m < 4; ++m)
#pragma unroll
                for (int bj = 0; bj < 2; ++bj)
#pragma unroll
                    for (int n = 0; n < 2; ++n)
#pragma unroll
                        for (int e = 0; e < 4; ++e) { const unsigned wa = ga[m][bj][n * 2 + (e >> 1)], wb = gb[m][bj][n * 2 + (e >> 1)];
                            const float a = (e & 1) ? __uint_as_float(wa & 0xffff0000u) : __uint_as_float(wa << 16), b = (e & 1) ? __uint_as_float(wb & 0xffff0000u) : __uint_as_float(wb << 16);
                            acc[ai][bj][m][n][e] *= (1.0f + __expf(-b)) * __builtin_amdgcn_rcpf(1.0f + __expf(-a)); }
            asm volatile("" ::: "memory");
        }
    }
    __device__ __forceinline__ void operator()(const f32x4 (&acc)[2][2][4][2], const Unit& u, int wr, int wc, int fr, int fq) const {
        const int row0 = u.pm * BM + wr * 64 + fr, col0 = u.pn * BM + wc * 32 + 8 * fq; const bf16_t* GT = (const bf16_t*)(ws + WS_GT); bf16_t* O = (bf16_t*)(ws + WS_MERGED);
#pragma unroll
        for (int ai = 0; ai < 2; ++ai) {
            u32x4 gb[4][2];
#pragma unroll
            for (int m = 0; m < 4; ++m)
#pragma unroll
                for (int bj = 0; bj < 2; ++bj) gb[m][bj] = *(const u32x4*)(GT + (size_t)(row0 + ai * HALF + m * 16) * 2048 + 1024 + col0 + bj * HALF);
#pragma unroll
            for (int m = 0; m < 4; ++m) { const int row = row0 + ai * HALF + m * 16; bf16_t* rowp = O + (size_t)row * 1024 + col0;
#pragma unroll
                for (int bj = 0; bj < 2; ++bj) { float o[8];
#pragma unroll
                    for (int n = 0; n < 2; ++n)
#pragma unroll
                        for (int e = 0; e < 4; ++e) { const unsigned wb = gb[m][bj][n * 2 + (e >> 1)]; const float b = (e & 1) ? __uint_as_float(wb & 0xffff0000u) : __uint_as_float(wb << 16);
                            o[n * 4 + e] = acc[ai][bj][m][n][e] * sigm(b); }
                    u32x4 w; w.x = cvt_pk_bf16(o[0], o[1]); w.y = cvt_pk_bf16(o[2], o[3]); w.z = cvt_pk_bf16(o[4], o[5]); w.w = cvt_pk_bf16(o[6], o[7]);
                    *(u32x4*)(rowp + bj * HALF) = w; } }
        }
    }
};
struct EpiF32 {
    static constexpr bool PERM = true, AFTER_DRAIN = false; static constexpr int MID_T = 0;
    unsigned char* ws;
    __device__ __forceinline__ void mid(f32x4 (&acc)[2][2][4][2], const Unit& u, int wr, int wc, int fr, int fq) const {}
    __device__ __forceinline__ void operator()(const f32x4 (&acc)[2][2][4][2], const Unit& u, int wr, int wc, int fr, int fq) const {
        const int row0 = u.pm * BM + wr * 64 + fr, col0 = u.pn * BM + wc * 32 + 8 * fq; bf16_t* Y = (bf16_t*)(ws + WS_Y); constexpr int ldc = DM;
#pragma unroll
        for (int ai = 0; ai < 2; ++ai)
#pragma unroll
            for (int m = 0; m < 4; ++m) { if (!((u.qm >> (2 * ai)) & 3)) continue; bf16_t* rowp = Y + (size_t)(row0 + ai * HALF + m * 16) * ldc + col0;
#pragma unroll
                for (int bj = 0; bj < 2; ++bj) { if (!((u.qm >> (2 * ai + bj)) & 1)) continue; const f32x4 v0 = acc[ai][bj][m][0], v1 = acc[ai][bj][m][1];
                    u32x4 w; w.x = cvt_pk_bf16(v0[0], v0[1]); w.y = cvt_pk_bf16(v0[2], v0[3]); w.z = cvt_pk_bf16(v1[0], v1[1]); w.w = cvt_pk_bf16(v1[2], v1[3]);
                    *(u32x4*)(rowp + bj * HALF) = w; } }
    }
};
struct EpiSwiglu {
    static constexpr bool PERM = true, AFTER_DRAIN = false; static constexpr int MID_T = 0;
    unsigned char* ws;
    __device__ __forceinline__ void mid(f32x4 (&acc)[2][2][4][2], const Unit& u, int wr, int wc, int fr, int fq) const {}
    __device__ __forceinline__ void operator()(const f32x4 (&acc)[2][2][4][2], const Unit& u, int wr, int wc, int fr, int fq) const {
        const int row0 = u.pm * BM + wr * 64 + fr, col0 = u.pn * HALF + wc * 32 + 8 * fq; bf16_t* Hh = (bf16_t*)(ws + WS_H); constexpr int ldh = DFF;
#pragma unroll
        for (int ai = 0; ai < 2; ++ai)
#pragma unroll
            for (int m = 0; m < 4; ++m) { if (!((u.qm >> (2 * ai)) & 3)) continue; const int row = row0 + ai * HALF + m * 16; float o[8];
#pragma unroll
                for (int n = 0; n < 2; ++n)
#pragma unroll
                    for (int e = 0; e < 4; ++e) { const float g = acc[ai][0][m][n][e], up = acc[ai][1][m][n][e]; o[n * 4 + e] = g * sigm(g) * up; }
                u32x4 w; w.x = cvt_pk_bf16(o[0], o[1]); w.y = cvt_pk_bf16(o[2], o[3]); w.z = cvt_pk_bf16(o[4], o[5]); w.w = cvt_pk_bf16(o[6], o[7]);
                *(u32x4*)(Hh + (size_t)row * ldh + col0) = w; }
    }
};

struct EpiAny {
    static constexpr bool PERM = true, AFTER_DRAIN = false; static constexpr int MID_T = 1;
    int kind, mid_t;
    unsigned char* ws;
    __device__ __forceinline__ void mid(f32x4 (&acc)[2][2][4][2], const Unit& u, int wr, int wc, int fr, int fq) const { EpiMerge{ws}.mid(acc, u, wr, wc, fr, fq); }
    __device__ __forceinline__ void operator()(const f32x4 (&acc)[2][2][4][2], const Unit& u, int wr, int wc, int fr, int fq) const {
        if (kind == 0) EpiProj{ws}(acc, u, wr, wc, fr, fq); else if (kind == 1) EpiMerge{ws}(acc, u, wr, wc, fr, fq); else if (kind == 2) EpiF32{ws}(acc, u, wr, wc, fr, fq); else EpiSwiglu{ws}(acc, u, wr, wc, fr, fq);
    }
};

template <class Epi, class Sched, bool ALIGN_EPI = false, bool SP2 = false>
__device__ __forceinline__ void gemm_phase(PG8_LAS unsigned char* lds, const Gemm g, const Sched& S, const Epi& E) {
    int tid_ = threadIdx.x; asm volatile("" : "+v"(tid_));
    const int tid = tid_, wid = __builtin_amdgcn_readfirstlane(tid >> 6), lane = tid & 63, wr = wid >> 2, wc = wid & 3, fr = lane & 15, fq = lane >> 4;
    const int K = g.K, nt = K / BK;
    unsigned voffA[2], voffB[2];
#pragma unroll
    for (int i = 0; i < 2; ++i) { int R, C; stage_rc(tid * 16 + i * 8192, R, C); const int Rb = Epi::PERM ? ((R & ~31) + perm32(R & 31)) : R;
        voffA[i] = (unsigned)(R * g.lda + C) * 2u; voffB[i] = (unsigned)(Rb * g.ldb + C) * 2u; }
    const size_t kstep = (size_t)(BK * 2);
    const size_t hstepA = (size_t)HALF * g.lda * 2, hstepB = (size_t)HALF * g.ldb * 2;
    const size_t tstepA = 2 * hstepA, tstepB = 2 * hstepB;
    const unsigned ldsw = (unsigned)wid * 1024u;
    const int aoff = lds_byte(wr * 64 + fr, fq * 8), boff = lds_byte(wc * 32 + fr, fq * 8);
#define PG8_SA(b, h) (((b) * 2 + (h)) * HTB)
#define PG8_SB(b, h) ((4 + (b) * 2 + (h)) * HTB)
#define PG8_STAGE(bufoff, gbase, voff) do { _Pragma("unroll") for (int _i = 0; _i < 2; ++_i) \
        __builtin_amdgcn_global_load_lds((const unsigned*)((const char*)(gbase) + (voff)[_i]), (PG8_LAS unsigned*)(lds + (bufoff) + ldsw + _i * 8192), 16, 0, 0); } while (0)
#define PG8_LDA(dst, b, h) do { _Pragma("unroll") for (int m = 0; m < 4; ++m) _Pragma("unroll") for (int k = 0; k < 2; ++k) dst[m][k] = *(const PG8_LAS bf16x8*)(lds + PG8_SA(b, h) + aoff + m * 2048 + k * 1024); } while (0)
#define PG8_LDB(dst, b, h) do { _Pragma("unroll") for (int n = 0; n < 2; ++n) _Pragma("unroll") for (int k = 0; k < 2; ++k) dst[n][k] = *(const PG8_LAS bf16x8*)(lds + PG8_SB(b, h) + boff + n * 2048 + k * 1024); } while (0)
#define PG8_MMA(ai, bj, At, Bt) do { __builtin_amdgcn_s_setprio(1); _Pragma("unroll") for (int m = 0; m < 4; ++m) _Pragma("unroll") for (int n = 0; n < 2; ++n) _Pragma("unroll") for (int k = 0; k < 2; ++k) \
        acc[ai][bj][m][n] = __builtin_amdgcn_mfma_f32_16x16x32_bf16(Bt[n][k], At[m][k], acc[ai][bj][m][n], 0, 0, 0); __builtin_amdgcn_s_setprio(0); } while (0)
#define PG8_WAIT_V(n) asm volatile("s_waitcnt vmcnt(" #n ")" ::: "memory")
#define PG8_WAIT_L(n) asm volatile("s_waitcnt lgkmcnt(" #n ")" ::: "memory")
#define PG8_BAR __builtin_amdgcn_s_barrier()
#define PG8_SCHED __builtin_amdgcn_sched_barrier(0)
    Unit cur, nxt; int ui = 0;
    if (!S.next(0, cur)) return;
    f32x4 acc[2][2][4][2];
#pragma unroll
    for (int a = 0; a < 2; ++a)
#pragma unroll
        for (int b = 0; b < 2; ++b)
#pragma unroll
            for (int m = 0; m < 4; ++m)
#pragma unroll
                for (int n = 0; n < 2; ++n) acc[a][b][m][n] = (f32x4){0.f, 0.f, 0.f, 0.f};
    bf16x8 At[4][2], B0[2][2], B1[2][2];
    const char* cA = (const char*)g.A + (size_t)cur.pm * tstepA; const char* cB = (const char*)g.Bt + (size_t)cur.pn * tstepB;
    S.a_ready(cur);
    if constexpr (SP2) {
        PG8_STAGE(PG8_SB(0, 0), cB, voffB); PG8_STAGE(PG8_SB(0, 1), cB + hstepB, voffB); PG8_STAGE(PG8_SA(0, 0), cA, voffA); PG8_STAGE(PG8_SA(0, 1), cA + hstepA, voffA);
        if (wr == 1) PG8_BAR;
        PG8_WAIT_V(2); PG8_BAR;
        PG8_STAGE(PG8_SB(1, 0), cB + kstep, voffB); PG8_STAGE(PG8_SA(1, 0), cA + kstep, voffA); PG8_STAGE(PG8_SB(1, 1), cB + hstepB + kstep, voffB);
        PG8_WAIT_V(6); PG8_BAR;
    } else {
        PG8_STAGE(PG8_SB(0, 0), cB, voffB); PG8_STAGE(PG8_SA(0, 0), cA, voffA); PG8_STAGE(PG8_SB(0, 1), cB + hstepB, voffB); PG8_STAGE(PG8_SA(0, 1), cA + hstepA, voffA);
        if (wr == 1) PG8_BAR;
        PG8_WAIT_V(4); PG8_BAR;
        PG8_STAGE(PG8_SB(1, 0), cB + kstep, voffB); PG8_STAGE(PG8_SA(1, 0), cA + kstep, voffA); PG8_STAGE(PG8_SB(1, 1), cB + hstepB + kstep, voffB);
        PG8_WAIT_V(6); PG8_BAR;
    }
    for (;;) {
        const bool has_next = S.next(ui + 1, nxt);
        const char* nA = has_next ? (const char*)g.A + (size_t)nxt.pm * tstepA : cA; const char* nB = has_next ? (const char*)g.Bt + (size_t)nxt.pn * tstepB : cB;
        for (int t = 0; t < nt; t += 2) {
            const bool last = (t == nt - 2);
            const char* a1 = cA + (size_t)(t + 1) * kstep;
            const char* a2 = last ? nA : cA + (size_t)(t + 2) * kstep; const char* b2 = last ? nB : cB + (size_t)(t + 2) * kstep;
            const char* a3 = a2 + kstep; const char* b3 = b2 + kstep;
            if (last && has_next) S.a_ready(nxt);
            if constexpr (Epi::MID_T > 0) { if (t == E.mid_t) E.mid(acc, cur, wr, wc, fr, fq); }
            if constexpr (SP2) {
            PG8_LDB(B0, 0, 0); PG8_LDB(B1, 0, 1); PG8_SCHED; PG8_LDA(At, 0, 0); PG8_STAGE(PG8_SA(1, 1), a1 + hstepA, voffA);
            PG8_WAIT_V(8); PG8_WAIT_L(0); PG8_BAR; if (cur.qm & 1) PG8_MMA(0, 0, At, B0); if (cur.qm & 2) PG8_MMA(0, 1, At, B1); PG8_BAR; PG8_SCHED;
            PG8_LDA(At, 0, 1); PG8_STAGE(PG8_SB(0, 0), b2, voffB); PG8_STAGE(PG8_SB(0, 1), b2 + hstepB, voffB); PG8_STAGE(PG8_SA(0, 0), a2, voffA);
            PG8_WAIT_V(8); PG8_WAIT_L(0); PG8_BAR; if (cur.qm & 4) PG8_MMA(1, 0, At, B0); if (cur.qm & 8) PG8_MMA(1, 1, At, B1); PG8_BAR; PG8_SCHED;
            PG8_LDB(B0, 1, 0); PG8_LDB(B1, 1, 1); PG8_SCHED; PG8_LDA(At, 1, 0); PG8_STAGE(PG8_SA(0, 1), a2 + hstepA, voffA);
            PG8_WAIT_V(8); PG8_WAIT_L(0); PG8_BAR; if (cur.qm & 1) PG8_MMA(0, 0, At, B0); if (cur.qm & 2) PG8_MMA(0, 1, At, B1); PG8_BAR; PG8_SCHED;
            PG8_LDA(At, 1, 1); PG8_STAGE(PG8_SB(1, 0), b3, voffB); PG8_STAGE(PG8_SB(1, 1), b3 + hstepB, voffB); PG8_STAGE(PG8_SA(1, 0), a3, voffA);
            PG8_WAIT_V(8); PG8_WAIT_L(0); PG8_BAR; if (cur.qm & 4) PG8_MMA(1, 0, At, B0); if (cur.qm & 8) PG8_MMA(1, 1, At, B1); PG8_BAR; PG8_SCHED;
            } else {
            PG8_LDB(B0, 0, 0); PG8_SCHED; PG8_LDA(At, 0, 0); PG8_STAGE(PG8_SA(1, 1), a1 + hstepA, voffA);
            PG8_WAIT_L(8); PG8_BAR; PG8_WAIT_L(0); PG8_MMA(0, 0, At, B0); PG8_BAR; PG8_SCHED;
            PG8_LDB(B1, 0, 1); PG8_STAGE(PG8_SB(0, 0), b2, voffB);
            PG8_BAR; PG8_WAIT_L(0); PG8_MMA(0, 1, At, B1); PG8_BAR;
            PG8_LDA(At, 0, 1); PG8_STAGE(PG8_SA(0, 0), a2, voffA);
            PG8_BAR; PG8_WAIT_L(0); PG8_MMA(1, 0, At, B0); PG8_BAR; PG8_SCHED;
            PG8_STAGE(PG8_SB(0, 1), b2 + hstepB, voffB);
            PG8_WAIT_V(6); PG8_BAR; PG8_MMA(1, 1, At, B1); PG8_BAR;
            PG8_LDB(B0, 1, 0); PG8_SCHED; PG8_LDA(At, 1, 0); PG8_STAGE(PG8_SA(0, 1), a2 + hstepA, voffA);
            PG8_WAIT_L(8); PG8_BAR; PG8_WAIT_L(0); PG8_MMA(0, 0, At, B0); PG8_BAR; PG8_SCHED;
            PG8_LDB(B1, 1, 1); PG8_STAGE(PG8_SB(1, 0), b3, voffB);
            PG8_BAR; PG8_WAIT_L(0); PG8_MMA(0, 1, At, B1); PG8_BAR;
            PG8_LDA(At, 1, 1); PG8_STAGE(PG8_SA(1, 0), a3, voffA);
            PG8_BAR; PG8_WAIT_L(0); PG8_MMA(1, 0, At, B0); PG8_BAR; PG8_SCHED;
            PG8_STAGE(PG8_SB(1, 1), b3 + hstepB, voffB);
            PG8_WAIT_V(6); PG8_BAR; PG8_MMA(1, 1, At, B1); PG8_BAR;
            }
        }
        if constexpr (ALIGN_EPI) { if (wr == 0) PG8_BAR; }
        if constexpr (!Epi::AFTER_DRAIN) { E(acc, cur, wr, wc, fr, fq); S.done(cur); }
        if (!has_next) break;
#pragma unroll
        for (int a = 0; a < 2; ++a)
#pragma unroll
            for (int b = 0; b < 2; ++b)
#pragma unroll
                for (int m = 0; m < 4; ++m)
#pragma unroll
                    for (int n = 0; n < 2; ++n) acc[a][b][m][n] = (f32x4){0.f, 0.f, 0.f, 0.f};
        cur = nxt; cA = nA; cB = nB; ++ui;
        if constexpr (ALIGN_EPI) { if (wr == 1) PG8_BAR; }
    }
    PG8_WAIT_V(0);
    if constexpr (!ALIGN_EPI) { if (wr == 0) PG8_BAR; }
    PG8_BAR;
#undef PG8_SA
#undef PG8_SB
#undef PG8_STAGE
#undef PG8_LDA
#undef PG8_LDB
#undef PG8_MMA
#undef PG8_WAIT_V
#undef PG8_WAIT_L
#undef PG8_BAR
#undef PG8_SCHED
}
}


#define LAS __attribute__((address_space(3)))
#define DI __device__ __forceinline__
typedef unsigned short bf16;
typedef unsigned v4u __attribute__((ext_vector_type(4)));
typedef unsigned v2u __attribute__((ext_vector_type(2)));
typedef float f32x4 __attribute__((ext_vector_type(4)));
#define LDS_WAIT() asm volatile("s_waitcnt lgkmcnt(0)" ::: "memory")

typedef __bf16 bfv2_ __attribute__((ext_vector_type(2)));
typedef float f32v2_ __attribute__((ext_vector_type(2)));
DI unsigned pk2(float lo, float hi) { return __builtin_bit_cast(unsigned, __builtin_convertvector((f32v2_){lo, hi}, bfv2_)); }
DI unsigned f2bf(float f) { unsigned u = __builtin_bit_cast(unsigned, f); return (u + 0x7fffu + ((u >> 16) & 1u)) >> 16; }
DI unsigned pk2s(float lo, float hi) { return f2bf(lo) | (f2bf(hi) << 16); }
DI float bflo(unsigned w) { return __uint_as_float(w << 16); }
DI float bfhi(unsigned w) { return __uint_as_float(w & 0xffff0000u); }
template <int K> DI float shx(float v) {
    if constexpr (K < 32) return __builtin_bit_cast(float, __builtin_amdgcn_ds_swizzle(__builtin_bit_cast(int, v), (K << 10) | 0x1f));
    else return __shfl_xor(v, 32);
}
DI float wave_sum(float v) {
    v += shx<1>(v); v += shx<2>(v); v += shx<4>(v); v += shx<8>(v); v += shx<16>(v); v += shx<32>(v);
    return v;
}
template <int N, int K> DI void wave_sum_step(float (&v)[N]) { float t[N];
#pragma unroll
    for (int i = 0; i < N; ++i) t[i] = shx<K>(v[i]);
#pragma unroll
    for (int i = 0; i < N; ++i) v[i] += t[i]; }
template <int N> DI void wave_sum_n(float (&v)[N]) {
    wave_sum_step<N, 1>(v); wave_sum_step<N, 2>(v); wave_sum_step<N, 4>(v); wave_sum_step<N, 8>(v); wave_sum_step<N, 16>(v); wave_sum_step<N, 32>(v);
}
DI float sigmoidf_(float x) { return __builtin_amdgcn_rcpf(1.0f + __expf(-x)); }
DI float siluf_(float x) { return x * __builtin_amdgcn_rcpf(1.0f + __expf(-x)); }
DI float rsq_(float x) { return __builtin_amdgcn_rsqf(x); }
DI float softplus_(float x) { const float y = __expf(x); return (y < 0.03f) ? y * (1.0f - y * (0.5f - y * (0.33333333f - 0.25f * y))) : __logf(1.0f + y); }

struct Args { const float* in[22]; float* out; unsigned char* ws; int ph_lo, ph_hi; };
struct KIn {
    DI const float* operator[](int k) const { auto kp = __builtin_amdgcn_kernarg_segment_ptr(); asm volatile("" : "+s"(kp));
        return ((const float* const __attribute__((address_space(4)))*)kp)[k]; }
};
struct Frame { LAS unsigned char* lds; int tid, lane, wave, G, bid; KIn in; float* out; unsigned char* ws; };

struct TrDesc { const float* W; const float* scale; bf16* WT; int ldsrc, k0, c0, ldk, n0, koff; };
DI void tr_load(const TrDesc& d, float (&wv_)[32], float (&sc_)[32], int lane) {
#pragma unroll
    for (int i = 0; i < 32; ++i) { const int kk = 2 * i + (lane >> 5); wv_[i] = d.W[(size_t)(d.k0 + kk) * d.ldsrc + d.c0 + (lane & 31)]; sc_[i] = d.scale ? d.scale[d.k0 + kk] : 1.0f; }
}
DI void tr_store(const TrDesc& d, const float (&wv_)[32], const float (&sc_)[32], LAS float* scr, int lane) {
#pragma unroll
    for (int i = 0; i < 32; ++i) { const int kk = 2 * i + (lane >> 5); scr[kk * 33 + (lane & 31)] = wv_[i] * sc_[i]; }
    LDS_WAIT(); asm volatile("" ::: "memory");
    const int c = lane & 7;
#pragma unroll
    for (int j = 0; j < 4; ++j) { const int n = (lane >> 3) + 8 * j; const LAS float* s = scr + (8 * c) * 33 + n;
        v4u o; o.x = pk2(s[0 * 33], s[1 * 33]); o.y = pk2(s[2 * 33], s[3 * 33]); o.z = pk2(s[4 * 33], s[5 * 33]); o.w = pk2(s[6 * 33], s[7 * 33]);
        *(v4u*)(d.WT + (size_t)(d.n0 + n) * d.ldk + d.koff + d.k0 + 8 * c) = o; }
    LDS_WAIT(); asm volatile("" ::: "memory");
}
constexpr int I_IN = 16 * 256, I_P = 16 * 32, I_FI = 16 * 176, I_FO = 44 * 32, I_L = I_IN + 3 * I_P + I_FI + I_FO, WT_CM = 3072;
DI TrDesc tr_decode(Frame& F, int it) {
    const int l = it / I_L; int r = it % I_L; unsigned char* wl = F.ws + WS_W + (size_t)l * W_LAYER; TrDesc d;
    if (r < I_IN) { const int kb = r / 256, nb = r % 256, n0 = 32 * nb, c0 = n0 + (n0 >= 4096 ? 16 : 0);
        d = TrDesc{F.in[5] + (size_t)l * DM * DIN, F.in[4] + l * DM, (bf16*)(wl + W_IN), DIN, 64 * kb, c0, DM, n0, 0}; return d; } r -= I_IN;
    if (r < I_P) { const int kb = r / 32, nb = r % 32; d = TrDesc{F.in[14] + (size_t)l * DM * DM, nullptr, (bf16*)(wl + W_PAB), DM, 64 * kb, 32 * nb, LD_PAB, 32 * nb, 0}; return d; } r -= I_P;
    if (r < I_P) { const int kb = r / 32, nb = r % 32; d = TrDesc{F.in[15] + (size_t)l * DM * DM, nullptr, (bf16*)(wl + W_PAB), DM, 64 * kb, 32 * nb, LD_PAB, 32 * nb, 1024}; return d; } r -= I_P;
    if (r < I_P) { const int kb = r / 32, nb = r % 32; d = TrDesc{F.in[16] + (size_t)l * DM * DM, nullptr, (bf16*)(wl + W_OUT), DM, 64 * kb, 32 * nb, DM, 32 * nb, 0}; return d; } r -= I_P;
    if (r < I_FI) { const int kb = r / 176, nb = r % 176, n0 = 32 * nb, p = n0 / 256, j = n0 % 256, c0 = (j < 128) ? 128 * p + j : DFF + 128 * p + (j - 128);
        d = TrDesc{F.in[19] + (size_t)l * DM * 2 * DFF, F.in[18] + l * DM, (bf16*)(wl + W_FIN), 2 * DFF, 64 * kb, c0, DM, n0, 0}; return d; } r -= I_FI;
    { const int kb = r / 32, nb = r % 32; d = TrDesc{F.in[20] + (size_t)l * DFF * DM, nullptr, (bf16*)(wl + W_FOUT), DM, 64 * kb, 32 * nb, DFF, 32 * nb, 0}; return d; }
}
DI void tr_range(Frame& F, int first, int last, int idx, int cnt) {
    LAS float* scr = (LAS float*)(F.lds + F.wave * 16384);
    const int it0 = first + idx;
    if (it0 < last) {
        float wa[32], sa[32], wb[32], sb[32];
        TrDesc d0 = tr_decode(F, it0); tr_load(d0, wa, sa, F.lane);
#pragma unroll 1
        for (int it = it0; it < last; it += cnt) {
            const bool hn = it + cnt < last;
            TrDesc d1 = d0; if (hn) { d1 = tr_decode(F, it + cnt); tr_load(d1, wb, sb, F.lane); }
            tr_store(d0, wa, sa, scr, F.lane);
            d0 = d1;
#pragma unroll
            for (int i = 0; i < 32; ++i) { wa[i] = wb[i]; sa[i] = sb[i]; }
        }
    }
}
DI void p0_weights(Frame& F) {
    tr_range(F, 0, I_L, F.bid * NWAVES + F.wave, F.G * NWAVES);
    for (int i = F.bid * 512 + F.tid; i < DEPTH * NH * 128 * 128; i += F.G * 512) { const int l = i >> 17, rem = i & 131071, ii = (rem >> 7) & 127, jj = rem & 127;
        ((bf16*)(F.ws + WS_W + (size_t)l * W_LAYER + W_SP))[rem] = (bf16)((jj <= ii) ? f2bf(F.in[12][i]) : 0u); }
}

constexpr int WAB_LDB = 2064, WAB_LO = 16 * WAB_LDB;
DI void load_wab_lds(Frame& F, int lab) {
    __syncthreads();
    { const float* wp = F.in[5] + (size_t)lab * DM * DIN + 4096; const float* nw = F.in[4] + lab * DM; float a_[32], b_[32];
#pragma unroll
      for (int j = 0; j < 32; ++j) { const int i = F.tid + j * (NWAVES * 64), c = i & 15, k = i >> 4; a_[j] = wp[(size_t)k * DIN + c]; b_[j] = nw[k]; }
#pragma unroll
      for (int j = 0; j < 32; ++j) { const int i = F.tid + j * (NWAVES * 64), c = i & 15, k = i >> 4; const float w = a_[j] * b_[j]; const unsigned hi = f2bf(w); const float lo = w - bflo(hi);
          *(LAS unsigned short*)(F.lds + c * WAB_LDB + 2 * k) = (unsigned short)hi; *(LAS unsigned short*)(F.lds + WAB_LO + c * WAB_LDB + 2 * k) = (unsigned short)f2bf(lo); } }
    __syncthreads();
}
DI void ab_tile(Frame& F, int lab, int t) {
    const int lane = F.lane, r = lane & 15, kg = lane >> 4;
    asm volatile("s_waitcnt vmcnt(0)" ::: "memory");
    const bf16* xp = (const bf16*)(F.ws + WS_XB) + (size_t)(16 * t + r) * DM + 8 * kg;
    const LAS unsigned char* bp = F.lds + r * WAB_LDB + 16 * kg;
    f32x4 acc = (f32x4){0.f, 0.f, 0.f, 0.f};
#pragma unroll 1
    for (int k0 = 0; k0 < 32; k0 += 8) {
        v4u xa[8];
#pragma unroll
        for (int kk = 0; kk < 8; ++kk) xa[kk] = *(const v4u*)(xp + 32 * (k0 + kk));
#pragma unroll
        for (int kk = 0; kk < 8; ++kk) { const pg8::bf16x8 av = __builtin_bit_cast(pg8::bf16x8, xa[kk]);
            const pg8::bf16x8 bh = *(const LAS pg8::bf16x8*)(bp + 64 * (k0 + kk)), bl = *(const LAS pg8::bf16x8*)(bp + WAB_LO + 64 * (k0 + kk));
            acc = __builtin_amdgcn_mfma_f32_16x16x32_bf16(av, bh, acc, 0, 0, 0); acc = __builtin_amdgcn_mfma_f32_16x16x32_bf16(av, bl, acc, 0, 0, 0); }
    }
    const float dtb = F.in[8][lab * NH + (r & 7)], alg = F.in[7][lab * NH + (r & 7)];
#pragma unroll
    for (int reg = 0; reg < 4; ++reg) { const float a = acc[reg]; float rr_;
        if (r < 8) { const float xx = a + dtb; const float sp = (xx > 20.f) ? xx : softplus_(xx); rr_ = -__expf(alg) * sp; } else rr_ = sigmoidf_(a);
        ((float*)(F.ws + WS_AB))[(size_t)(16 * t + 4 * kg + reg) * 16 + r] = rr_; }
}
constexpr int RB = 4;
DI void rowprep(Frame& F, const f32x4 (&v)[RB][4], const int (&row)[RB], const bool (&ok)[RB], int lab) {
    float s[RB];
#pragma unroll
    for (int k = 0; k < RB; ++k) { s[k] = 0.f;
#pragma unroll
        for (int j = 0; j < 4; ++j) s[k] += (v[k][j].x * v[k][j].x + v[k][j].y * v[k][j].y) + (v[k][j].z * v[k][j].z + v[k][j].w * v[k][j].w); }
    wave_sum_n<RB>(s);
    float rstd[RB];
#pragma unroll
    for (int k = 0; k < RB; ++k) { rstd[k] = rsq_(s[k] * (1.0f / DM) + 1e-6f);
        if (ok[k]) {
            v2u* xb = (v2u*)((bf16*)(F.ws + WS_XB) + (size_t)row[k] * DM) + F.lane;
#pragma unroll
            for (int j = 0; j < 4; ++j) { const f32x4 t = v[k][j] * rstd[k]; v2u o; o.x = pk2(t.x, t.y); o.y = pk2(t.z, t.w); xb[64 * j] = o; } } }
    (void)lab;
}
DI void p0_batch(Frame& F, const int (&row)[RB], const bool (&ok)[RB]) {
    f32x4 v[RB][4];
#pragma unroll
    for (int k = 0; k < RB; ++k) { const float* xr = (row[k] < TP) ? F.in[0] + (size_t)row[k] * DM : F.in[1] + (size_t)(row[k] - TP) * DM;
#pragma unroll
        for (int j = 0; j < 4; ++j) v[k][j] = ((const f32x4*)xr)[F.lane + 64 * j]; }
    rowprep(F, v, row, ok, 0);
}
DI void p0_rows(Frame& F) {
    load_wab_lds(F, 0);
    const int slot = F.wave * F.G + F.bid, NGW = F.G * NWAVES;
    for (int t = slot; t < TT / 16; t += NGW) {
#pragma unroll 1
        for (int it = 0; it < 4; ++it) { int row[RB]; bool ok[RB];
#pragma unroll
            for (int k = 0; k < RB; ++k) { row[k] = 16 * t + 4 * it + k; ok[k] = true; }
            p0_batch(F, row, ok); }
        ab_tile(F, 0, t);
    }
}
DI void rows_batch(Frame& F, const bf16* Y, const f32x4 (&ww)[4], bool x_from_in, bool fin, int lab, const int (&row)[RB], const bool (&ok)[RB]) {
    f32x4 x[RB][4]; float s[RB];
    {
        f32x4 y[RB][4];
#pragma unroll
        for (int k = 0; k < RB; ++k) {
            const float* xr = x_from_in ? ((row[k] < TP) ? F.in[0] + (size_t)row[k] * DM : F.in[1] + (size_t)(row[k] - TP) * DM) : F.out + (size_t)row[k] * DM;
            s[k] = 0.f;
#pragma unroll
            for (int j = 0; j < 4; ++j) { const v2u yw = ((const v2u*)(Y + (size_t)row[k] * DM))[F.lane + 64 * j]; y[k][j] = (f32x4){bflo(yw.x), bfhi(yw.x), bflo(yw.y), bfhi(yw.y)}; x[k][j] = ((const f32x4*)xr)[F.lane + 64 * j];
                s[k] += (y[k][j].x * y[k][j].x + y[k][j].y * y[k][j].y) + (y[k][j].z * y[k][j].z + y[k][j].w * y[k][j].w); } }
        wave_sum_n<RB>(s);
#pragma unroll
        for (int k = 0; k < RB; ++k) { const float ry = rsq_(s[k] * (1.0f / DM) + 1e-6f);
#pragma unroll
            for (int j = 0; j < 4; ++j) { x[k][j] = x[k][j] + y[k][j] * ry * ww[j]; if (ok[k]) ((f32x4*)(F.out + (size_t)row[k] * DM))[F.lane + 64 * j] = x[k][j]; } }
    }
    if (!fin) rowprep(F, x, row, ok, lab);
}
DI void rows_residual(Frame& F, const bf16* Y, const float* w, bool x_from_in, bool fin, int lab) {
    const bool tilemaj = !fin && lab >= 0;
    if (tilemaj) load_wab_lds(F, lab);
    const int gw = F.bid * NWAVES + F.wave, NGW = F.G * NWAVES;
    f32x4 ww[4];
#pragma unroll
    for (int j = 0; j < 4; ++j) ww[j] = ((const f32x4*)w)[F.lane + 64 * j];
    if (tilemaj) {
        const int slot = F.wave * F.G + F.bid;
        for (int t = slot; t < TT / 16; t += NGW) {
#pragma unroll 1
            for (int it = 0; it < 4; ++it) { int row[RB]; bool ok[RB];
#pragma unroll
                for (int k = 0; k < RB; ++k) { row[k] = 16 * t + 4 * it + k; ok[k] = true; }
                rows_batch(F, Y, ww, x_from_in, fin, lab, row, ok); }
            ab_tile(F, lab, t);
        }
    } else {
        for (int base = gw; base < TT; base += NGW * RB) { int row[RB]; bool ok[RB];
#pragma unroll
            for (int k = 0; k < RB; ++k) { const int r = base + k * NGW; ok[k] = r < TT; row[k] = ok[k] ? r : base; }
            rows_batch(F, Y, ww, x_from_in, fin, lab, row, ok); }
    }
}

typedef short s16x4 __attribute__((ext_vector_type(4)));
typedef short bf16x8 __attribute__((ext_vector_type(8)));
typedef float f32x8 __attribute__((ext_vector_type(8)));
typedef float f32x16 __attribute__((ext_vector_type(16)));
typedef float f32x2_ __attribute__((ext_vector_type(2)));
typedef __bf16 bfv8 __attribute__((ext_vector_type(8)));
#define MFMA32(a, b, c) __builtin_amdgcn_mfma_f32_32x32x16_bf16((a), (b), (c), 0, 0, 0)
DI int crow(int reg, int h) { return (reg & 3) + 8 * (reg >> 2) + 4 * h; }
DI bf16x8 pack_lo(const f32x16& x) { const f32x8 v = __builtin_shufflevector(x, x, 0, 1, 2, 3, 4, 5, 6, 7); return __builtin_bit_cast(bf16x8, __builtin_convertvector(v, bfv8)); }
DI bf16x8 pack_hi(const f32x16& x) { const f32x8 v = __builtin_shufflevector(x, x, 8, 9, 10, 11, 12, 13, 14, 15); return __builtin_bit_cast(bf16x8, __builtin_convertvector(v, bfv8)); }
DI f32x16 zero16() { f32x16 z;
#pragma unroll
    for (int i = 0; i < 16; ++i) z[i] = 0.f; return z; }

DI void e1_conv_sample(Frame& F, int l) {
    const int gw = F.bid * NWAVES + F.wave, NGW = F.G * NWAVES, lane = F.lane;
    const bf16* raw = (const bf16*)(F.ws + WS_QKVRAW); bf16* qc = (bf16*)(F.ws + WS_QKVS);
    const float* cw = F.in[6] + (size_t)l * 4 * DCONV; const float* scin = F.in[3];
    for (int it = gw; it < TSM * 3; it += NGW) {
        const int srow = it / 3, part = it - 3 * srow, row = TP + srow, seq = srow / TS_, t = srow % TS_;
        const float* sc = scin + ((size_t)l * NS + seq) * 3 * DCONV;
        float* sco = F.out + O_SCS + ((size_t)l * NS + seq) * 3 * DCONV;
#pragma unroll 1
        for (int s0 = 0; s0 < 8; s0 += 4) {
            unsigned xw[4][4]; f32x2_ sv[4][4], wv[4][4];
#pragma unroll
            for (int i = 0; i < 4; ++i) { const int tt = t - 3 + i, si = (t + i) < 3 ? (t + i) : 2;
#pragma unroll
                for (int sg = 0; sg < 4; ++sg) { const int ch = part * 1024 + (s0 + sg) * 128 + 2 * lane;
                    xw[i][sg] = *(const unsigned*)(raw + (size_t)(tt >= 0 ? row - 3 + i : row) * DCONV + ch);
                    sv[i][sg] = *(const f32x2_*)(sc + (size_t)si * DCONV + ch); wv[i][sg] = *(const f32x2_*)(cw + i * DCONV + ch); } }
            float a0[4], a1[4], ss[4];
#pragma unroll
            for (int sg = 0; sg < 4; ++sg) { a0[sg] = 0.f; a1[sg] = 0.f;
#pragma unroll
                for (int i = 0; i < 4; ++i) { const int tt = t - 3 + i; const float x0 = tt >= 0 ? bflo(xw[i][sg]) : sv[i][sg].x, x1 = tt >= 0 ? bfhi(xw[i][sg]) : sv[i][sg].y; a0[sg] += wv[i][sg].x * x0; a1[sg] += wv[i][sg].y * x1; }
                if (t >= TS_ - 3) { const int ch = part * 1024 + (s0 + sg) * 128 + 2 * lane; *(f32x2_*)(sco + (size_t)(t - (TS_ - 3)) * DCONV + ch) = (f32x2_){bflo(xw[3][sg]), bfhi(xw[3][sg])}; }
                a0[sg] = siluf_(a0[sg]); a1[sg] = siluf_(a1[sg]); ss[sg] = a0[sg] * a0[sg] + a1[sg] * a1[sg]; }
            if (part < 2) wave_sum_n<4>(ss);
#pragma unroll
            for (int sg = 0; sg < 4; ++sg) { const float scl = (part < 2) ? rsq_(ss[sg] + 1e-6f) * (part == 0 ? 0.08838834764831845f : 1.0f) : 1.0f;
                *(unsigned*)(qc + (size_t)srow * DCONV + part * 1024 + (s0 + sg) * 128 + 2 * lane) = pk2(a0[sg] * scl, a1[sg] * scl); }
        }
    }
}

constexpr int PL_KN = 0, PL_QS = 17408, PL_RT = 34816, PL_AF = 71680, PL_AB = 89088, PL_T = 91648, PL_T0T = 100864, PL_G = 103424, PL_RT2 = 103936, PL_RTB = PL_RT2 - PL_RT;
constexpr int KN_LD = 136, RT_LD = 72, AF_LD = 68, AB_LD = 40, T_LD = 72, T0T_LD = 40;
DI bf16x8 lds_frag(const LAS unsigned char* p) { return *(const LAS bf16x8*)p; }
DI bf16x8 lds_frag_perm(const LAS unsigned char* p) {
    const s16x4 lo = *(const LAS s16x4*)p, hi = *(const LAS s16x4*)(p + 16); return __builtin_shufflevector(lo, hi, 0, 1, 2, 3, 4, 5, 6, 7); }
struct PrepIn { unsigned xr[3][11]; float gl, bl; };
DI void prep_load(Frame& F, int unit, PrepIn& pi) {
    const int c = unit & 31, h = (unit >> 5) & 7, b = unit >> 8, row0 = b * SEQ + 64 * c, i0 = 8 * F.wave, cp = F.lane;
    const bf16* raw = (const bf16*)(F.ws + WS_QKVRAW); const float* ab = (const float*)(F.ws + WS_AB);
    pi.gl = ab[(size_t)(row0 + F.lane) * 16 + h]; pi.bl = ab[(size_t)(row0 + F.lane) * 16 + 8 + h];
#pragma unroll
    for (int a = 0; a < 3; ++a) { const int col = a * 1024 + h * HD + 2 * cp;
#pragma unroll
        for (int ii = 0; ii < 11; ++ii) { const int tt = 64 * c + i0 - 3 + ii; pi.xr[a][ii] = *(const unsigned*)(raw + (size_t)(tt >= 0 ? row0 + i0 - 3 + ii : row0) * DCONV + col); } }
}
DI void prep_s1(Frame& F, int l, int unit, PrepIn& pi, int next_unit, int rtoff) {
    const int c = unit & 31, h = (unit >> 5) & 7, b = unit >> 8;
    const int row0 = b * SEQ + 64 * c, w = F.wave, lane = F.lane, r = lane & 31, hh = lane >> 5;
    LAS unsigned char* lds = F.lds;
    unsigned char* rec = F.ws + WS_REC + (size_t)unit * REC_BYTES;
    (void)c; (void)h; (void)b; (void)row0; (void)r; (void)hh; (void)rec; (void)w; (void)lds;
    const float* cw = F.in[6] + (size_t)l * 4 * DCONV;
    const float gl = pi.gl, bl = pi.bl;
    float gc = gl;
#pragma unroll
    for (int o = 1; o < 64; o <<= 1) { const float t = __shfl_up(gc, o); if (lane >= o) gc += t; }
    const float glast = __shfl(gc, 63);
    if (w == 0) { ((LAS float*)(lds + PL_G))[lane] = gc; ((LAS float*)(lds + PL_G))[64 + lane] = bl; if (lane == 0) ((float*)(F.ws + WS_EG))[unit] = __expf(glast); }
    {
        const int cp = lane, i0 = 8 * w;
#pragma unroll
        for (int a = 0; a < 3; ++a) {
            const int col = a * 1024 + h * HD + 2 * cp; float x[11][2];
#pragma unroll
            for (int ii = 0; ii < 11; ++ii) { const int tt = 64 * c + i0 - 3 + ii; x[ii][0] = tt >= 0 ? bflo(pi.xr[a][ii]) : 0.f; x[ii][1] = tt >= 0 ? bfhi(pi.xr[a][ii]) : 0.f; }
            float wv[4][2];
#pragma unroll
            for (int i = 0; i < 4; ++i) { const f32x2_ t2 = *(const f32x2_*)(cw + i * DCONV + col); wv[i][0] = t2.x; wv[i][1] = t2.y; }
            if (c == 31 && w == 7) {
                float* sco = F.out + O_SCP + ((size_t)l * NB + b) * 3 * DCONV + col;
#pragma unroll
                for (int j = 0; j < 3; ++j) { sco[(size_t)j * DCONV] = x[8 + j][0]; sco[(size_t)j * DCONV + 1] = x[8 + j][1]; }
            }
            float y[8][2];
#pragma unroll
            for (int rr = 0; rr < 8; ++rr)
#pragma unroll
                for (int e = 0; e < 2; ++e) { float acc = 0.f;
#pragma unroll
                    for (int i = 0; i < 4; ++i) acc += wv[i][e] * x[rr + i][e];
                    y[rr][e] = siluf_(acc); }
            if (a < 2) {
                float ssq[8];
#pragma unroll
                for (int rr = 0; rr < 8; ++rr) ssq[rr] = y[rr][0] * y[rr][0] + y[rr][1] * y[rr][1];
                wave_sum_n<8>(ssq);
#pragma unroll
                for (int rr = 0; rr < 8; ++rr) { const float sc = rsq_(ssq[rr] + 1e-6f) * (a == 0 ? 0.08838834764831845f : 1.0f); y[rr][0] *= sc; y[rr][1] *= sc; }
            }
            if (a == 0) {
#pragma unroll
                for (int rr = 0; rr < 8; ++rr) { const int i = i0 + rr; const float ei = __expf(__shfl(gc, i0 + rr));
                    *(LAS unsigned*)(lds + PL_QS + (i * KN_LD + 2 * cp) * 2) = pk2(y[rr][0], y[rr][1]);
                    const int dk = 2 * cp, fidx = (((i >> 5) * 4 + (dk >> 5)) * 2 + ((dk >> 4) & 1)), ln = (i & 31) + 32 * ((dk >> 2) & 1), el = ((dk >> 3) & 1) * 4 + (dk & 3);
                    *(unsigned*)(rec + R_QG + fidx * 1024 + ln * 16 + el * 2) = pk2(y[rr][0] * ei, y[rr][1] * ei); }
            } else {
                unsigned r0[4], r1[4];
#pragma unroll
                for (int rr = 0; rr < 8; ++rr) { const float bi_ = __shfl(bl, i0 + rr); const float f = (a == 1) ? bi_ * __expf(__shfl(gc, i0 + rr)) : bi_; const unsigned p0 = f2bf(y[rr][0] * f), p1 = f2bf(y[rr][1] * f);
                    if (rr & 1) { r0[rr >> 1] |= p0 << 16; r1[rr >> 1] |= p1 << 16; } else { r0[rr >> 1] = p0; r1[rr >> 1] = p1; } }
                const int n0 = (a == 1 ? 128 : 0) + 2 * cp;
                *(LAS v4u*)(lds + PL_RT + rtoff + (n0 * RT_LD + i0) * 2) = (v4u){r0[0], r0[1], r0[2], r0[3]};
                *(LAS v4u*)(lds + PL_RT + rtoff + ((n0 + 1) * RT_LD + i0) * 2) = (v4u){r1[0], r1[1], r1[2], r1[3]};
                if (a == 1) {
#pragma unroll
                    for (int rr = 0; rr < 8; ++rr) *(LAS unsigned*)(lds + PL_KN + ((i0 + rr) * KN_LD + 2 * cp) * 2) = pk2(y[rr][0], y[rr][1]);
                    float d[8];
#pragma unroll
                    for (int rr = 0; rr < 8; ++rr) d[rr] = __expf(glast - __shfl(gc, i0 + rr));
#pragma unroll
                    for (int e = 0; e < 2; ++e) { const int dk = 2 * cp + e; const int fidx = ((dk >> 5) * 2 + (i0 >> 5)) * 2 + ((i0 >> 4) & 1), el = ((i0 >> 3) & 1) * 4;
                        *(v2u*)(rec + R_KGT + fidx * 1024 + ((dk & 31)) * 16 + el * 2) = (v2u){pk2(y[0][e] * d[0], y[1][e] * d[1]), pk2(y[2][e] * d[2], y[3][e] * d[3])};
                        *(v2u*)(rec + R_KGT + fidx * 1024 + ((dk & 31) + 32) * 16 + el * 2) = (v2u){pk2(y[4][e] * d[4], y[5][e] * d[5]), pk2(y[6][e] * d[6], y[7][e] * d[7])}; }
                }
            }
        }
    }
    if (next_unit >= 0) prep_load(F, next_unit, pi);
}
DI void prep_s2(Frame& F, int unit) {
    const int c = unit & 31, h = (unit >> 5) & 7, b = unit >> 8;
    const int row0 = b * SEQ + 64 * c, w = F.wave, lane = F.lane, r = lane & 31, hh = lane >> 5;
    LAS unsigned char* lds = F.lds;
    unsigned char* rec = F.ws + WS_REC + (size_t)unit * REC_BYTES;
    (void)c; (void)h; (void)b; (void)row0; (void)r; (void)hh; (void)rec; (void)w; (void)lds;
    if (w < 6) {
        int ln_ = lane; asm volatile("" : "+v"(ln_)); const int r = ln_ & 31, hh = ln_ >> 5;
        const int ta = (w == 1 || w == 2 || w == 5) ? 1 : 0, tb = (w == 2 || w == 4 || w == 5) ? 1 : 0; const bool iskk = w < 3;
        f32x16 acc = zero16();
        const LAS unsigned char* ap = lds + PL_KN + ((32 * ta + r) * KN_LD + 8 * hh) * 2;
        const LAS unsigned char* bp = lds + (iskk ? PL_KN : PL_QS) + ((32 * tb + r) * KN_LD + 8 * hh) * 2;
#pragma unroll
        for (int ks = 0; ks < 8; ++ks) acc = MFMA32(lds_frag(ap + ks * 32), lds_frag(bp + ks * 32), acc);
        const LAS float* gcl = (const LAS float*)(lds + PL_G); const LAS float* bel = gcl + 64;
        const int cidx = 32 * tb + r; const float gcc = gcl[cidx];
        if (iskk) {
#pragma unroll
            for (int reg = 0; reg < 16; ++reg) { const int i = 32 * ta + crow(reg, hh); const float v = (i > cidx) ? bel[i] * acc[reg] * __expf(gcl[i] - gcc) : 0.f;
                *(LAS float*)(lds + PL_AF + (i * AF_LD + cidx) * 4) = v;
                if (w == 1) *(LAS unsigned short*)(lds + PL_AB + ((i - 32) * AB_LD + cidx) * 2) = (unsigned short)f2bf(v); }
        } else {
#pragma unroll
            for (int reg = 0; reg < 16; ++reg) { const int j = 32 * ta + crow(reg, hh); acc[reg] = (cidx >= j) ? acc[reg] * __expf(gcc - gcl[j]) : 0.f; }
            unsigned char* dst = rec + R_QK + (size_t)((tb * 2 + ta) * 2) * 1024 + ln_ * 16;
            *(bf16x8*)dst = pack_lo(acc); *(bf16x8*)(dst + 1024) = pack_hi(acc);
        }
    } else if (w == 6) {
        const bf16x8 z = {0, 0, 0, 0, 0, 0, 0, 0}; unsigned char* dst = rec + R_QK + (size_t)((0 * 2 + 1) * 2) * 1024 + lane * 16; *(bf16x8*)dst = z; *(bf16x8*)(dst + 1024) = z;
    }
}
DI void prep_s34(Frame& F) {
    const int w = 0, lane = F.lane, r = lane & 31, hh = lane >> 5; LAS unsigned char* lds = F.lds;
    if (w == 0) {
        const int bsel = hh, cc = r; float T[32];
        const LAS float* arow = (const LAS float*)(lds + PL_AF) + (32 * bsel) * AF_LD + 32 * bsel;
#pragma unroll
        for (int i = 0; i < 32; ++i) { float acc = (i == cc) ? 1.f : 0.f;
#pragma unroll
            for (int q = 0; q < (i + 3) / 4; ++q) { const f32x4 a4 = *(const LAS f32x4*)(arow + i * AF_LD + 4 * q);
#pragma unroll
                for (int e = 0; e < 4; ++e) if (4 * q + e < i) acc -= a4[e] * T[4 * q + e]; }
            T[i] = acc; if ((i & 1) == 1) asm volatile("" ::: "memory"); }
#pragma unroll
        for (int i = 0; i < 32; ++i) { *(LAS unsigned short*)(lds + PL_T + ((32 * bsel + i) * T_LD + 32 * bsel + cc) * 2) = (unsigned short)f2bf(T[i]);
            if (bsel == 0) *(LAS unsigned short*)(lds + PL_T + (i * T_LD + 32 + cc) * 2) = 0; }
        if (bsel == 0) {
#pragma unroll
            for (int q = 0; q < 4; ++q) *(LAS v4u*)(lds + PL_T0T + (cc * T0T_LD + 8 * q) * 2) = (v4u){pk2s(T[8 * q], T[8 * q + 1]), pk2s(T[8 * q + 2], T[8 * q + 3]), pk2s(T[8 * q + 4], T[8 * q + 5]), pk2s(T[8 * q + 6], T[8 * q + 7])}; }
    }
    if (w == 0) {
        int ln_ = lane; asm volatile("" : "+v"(ln_)); const int r = ln_ & 31, hh = ln_ >> 5;
        f32x16 P = zero16();
#pragma unroll
        for (int s2 = 0; s2 < 2; ++s2) P = MFMA32(lds_frag(lds + PL_AB + (r * AB_LD + 16 * s2 + 8 * hh) * 2), lds_frag(lds + PL_T0T + (r * T0T_LD + 16 * s2 + 8 * hh) * 2), P);
        f32x16 X = zero16();
        X = MFMA32(lds_frag_perm(lds + PL_T + ((32 + r) * T_LD + 32 + 4 * hh) * 2), pack_lo(P), X);
        X = MFMA32(lds_frag_perm(lds + PL_T + ((32 + r) * T_LD + 32 + 16 + 4 * hh) * 2), pack_hi(P), X);
#pragma unroll
        for (int reg = 0; reg < 16; ++reg) *(LAS unsigned short*)(lds + PL_T + ((32 + crow(reg, hh)) * T_LD + r) * 2) = (unsigned short)f2bf(-X[reg]);
    }
}
DI void prep_s5(Frame& F, int unit, int rtoff) {
    const int c = unit & 31, h = (unit >> 5) & 7, b = unit >> 8;
    const int row0 = b * SEQ + 64 * c, w = F.wave, lane = F.lane, r = lane & 31, hh = lane >> 5;
    LAS unsigned char* lds = F.lds;
    unsigned char* rec = F.ws + WS_REC + (size_t)unit * REC_BYTES;
    (void)c; (void)h; (void)b; (void)row0; (void)r; (void)hh; (void)rec; (void)w; (void)lds;
    int ln5_ = lane; asm volatile("" : "+v"(ln5_));
    if (w < 4) {
        const int r = ln5_ & 31, hh = ln5_ >> 5;
#pragma unroll
        for (int mt = 0; mt < 2; ++mt) { f32x16 acc = zero16();
#pragma unroll
            for (int ks = 0; ks < 4; ++ks) if (ks < 2 * (mt + 1)) acc = MFMA32(lds_frag(lds + PL_T + ((32 * mt + r) * T_LD + 16 * ks + 8 * hh) * 2), lds_frag(lds + PL_RT + rtoff + ((32 * w + r) * RT_LD + 16 * ks + 8 * hh) * 2), acc);
            unsigned char* dst = rec + R_U + (size_t)((w * 2 + mt) * 64 + lane) * 32;
            *(bf16x8*)dst = pack_lo(acc); *(bf16x8*)(dst + 16) = pack_hi(acc); }
    } else {
        const int kt = w - 4, r = ln5_ & 31, hh = ln5_ >> 5;
#pragma unroll
        for (int it = 0; it < 2; ++it) { f32x16 acc = zero16();
#pragma unroll
            for (int ks = 0; ks < 4; ++ks) if (ks < 2 * (it + 1)) acc = MFMA32(lds_frag(lds + PL_RT + rtoff + ((128 + 32 * kt + r) * RT_LD + 16 * ks + 8 * hh) * 2), lds_frag(lds + PL_T + ((32 * it + r) * T_LD + 16 * ks + 8 * hh) * 2), acc);
#pragma unroll
            for (int reg = 0; reg < 16; ++reg) acc[reg] = -acc[reg];
            unsigned char* dst = rec + R_WN + (size_t)(((it * 4 + kt) * 2) * 64 + lane) * 16;
            *(bf16x8*)dst = pack_lo(acc); *(bf16x8*)(dst + 1024) = pack_hi(acc); }
    }
}
DI void prep_phase(Frame& F, int l) {
    constexpr int NU = NB * NH * 32;
    if (F.bid < NU) {
        PrepIn pi; const int u0 = F.bid;
        prep_load(F, u0, pi);
        prep_s1(F, l, u0, pi, (u0 + F.G < NU) ? u0 + F.G : -1, 0); __syncthreads();
        prep_s2(F, u0); __syncthreads();
#pragma unroll 1
        for (int k = 0; ; ++k) { const int u = u0 + k * F.G, un = u + F.G; const bool has_next = un < NU;
            if (F.wave == 0) prep_s34(F);
            if (has_next) prep_s1(F, l, un, pi, (un + F.G < NU) ? un + F.G : -1, ((k + 1) & 1) * PL_RTB);
            __syncthreads();
            prep_s5(F, u, (k & 1) * PL_RTB);
            if (has_next) prep_s2(F, un);
            __syncthreads();
            if (!has_next) break;
        }
    }
    e1_conv_sample(F, l);
}

constexpr int SC_OB = 2 * REC_FRAG_BYTES, OB_LD = 136, OB_BYTES = 64 * OB_LD * 2, SC_DNW = SC_OB + 2 * OB_BYTES;
DI void scan_finish(Frame& F, int l, int b, int h, int c, const LAS unsigned char* ob, const v4u (&zr)[4], int t4) {
    const int row = t4 >> 2, seg = t4 & 3;
    const LAS float* dnw = (const LAS float*)(F.lds + SC_DNW) + seg * 32;
    v4u ov[4]; float ss = 0.f;
#pragma unroll
    for (int q = 0; q < 4; ++q) { ov[q] = *(const LAS v4u*)(ob + row * (OB_LD * 2) + seg * 64 + q * 16);
#pragma unroll
        for (int e = 0; e < 4; ++e) { const float a = bflo(ov[q][e]), bb = bfhi(ov[q][e]); ss += a * a + bb * bb; } }
    ss += __shfl_xor(ss, 1); ss += __shfl_xor(ss, 2);
    const float rs = rsq_(ss * (1.0f / HD) + 1e-6f);
    bf16* dst = (bf16*)(F.ws + WS_OAB) + (size_t)(b * SEQ + 64 * c + row) * LD_OAB + h * HD + seg * 32;
#pragma unroll
    for (int q = 0; q < 4; ++q) { v4u o4;
#pragma unroll
        for (int e = 0; e < 4; ++e) { const float a = bflo(ov[q][e]) * rs * dnw[q * 8 + 2 * e] * siluf_(bflo(zr[q][e])), bb = bfhi(ov[q][e]) * rs * dnw[q * 8 + 2 * e + 1] * siluf_(bfhi(zr[q][e])); o4[e] = pk2(a, bb); }
        *(v4u*)(dst + q * 8) = o4; }
}
DI void scan_unit(Frame& F, int l, int bh) {
    const int w = F.wave, lane = F.lane, r = lane & 31, hh = lane >> 5, b = bh >> 3, h = bh & 7;
    LAS unsigned char* lds = F.lds;
    const unsigned char* rec0 = F.ws + WS_REC + (size_t)bh * 32 * REC_BYTES;
    const float egl = ((const float*)(F.ws + WS_EG))[bh * 32 + (lane & 31)];
    const int t4 = F.tid - 256;
    const bf16* zbase = (const bf16*)(F.ws + WS_Z) + (size_t)(b * SEQ + (t4 >> 2)) * DM + h * HD + (t4 & 3) * 32;
    f32x16 S[4];
#pragma unroll
    for (int k = 0; k < 4; ++k) S[k] = zero16();
#define SCAN_DMA(cidx, buf) do { const unsigned char* src_ = rec0 + (size_t)(cidx) * REC_BYTES; _Pragma("unroll") for (int it_ = 0; it_ < 7; ++it_) \
        __builtin_amdgcn_global_load_lds((const unsigned*)(src_ + (it_ * 8 + w) * 1024 + lane * 16), (LAS unsigned*)(lds + (buf) * REC_FRAG_BYTES + (it_ * 8 + w) * 1024), 16, 0, 0); } while (0)
    SCAN_DMA(0, 0);
    v4u pf[4];
    if (F.tid < HD) ((LAS float*)(lds + SC_DNW))[F.tid] = F.in[9][l * HD + F.tid];
    if (w < 4) {
#pragma unroll
        for (int mt = 0; mt < 2; ++mt) { const unsigned char* up = rec0 + R_U + (size_t)((w * 2 + mt) * 64 + lane) * 32; pf[mt * 2] = *(const v4u*)up; pf[mt * 2 + 1] = *(const v4u*)(up + 16); }
    }
#pragma unroll 1
    for (int c = 0; c < 32; ++c) {
        asm volatile("s_waitcnt vmcnt(0)" ::: "memory");
        __syncthreads();
        if (w < 4) {
            f32x16 vn[2];
#pragma unroll
            for (int mt = 0; mt < 2; ++mt)
#pragma unroll
                for (int q = 0; q < 2; ++q)
#pragma unroll
                    for (int e = 0; e < 4; ++e) { vn[mt][q * 8 + 2 * e] = bflo(pf[mt * 2 + q][e]); vn[mt][q * 8 + 2 * e + 1] = bfhi(pf[mt * 2 + q][e]); }
            __builtin_amdgcn_sched_barrier(0);
            if (c + 1 < 32) {
                SCAN_DMA(c + 1, (c + 1) & 1);
#pragma unroll
                for (int mt = 0; mt < 2; ++mt) { const unsigned char* up = rec0 + (size_t)(c + 1) * REC_BYTES + R_U + (size_t)((w * 2 + mt) * 64 + lane) * 32; pf[mt * 2] = *(const v4u*)up; pf[mt * 2 + 1] = *(const v4u*)(up + 16); }
            }
            __builtin_amdgcn_sched_barrier(0);
            const LAS unsigned char* fb = lds + (c & 1) * REC_FRAG_BYTES + lane * 16;
            const float eg = __shfl(egl, c);
            f32x16 o[2]; o[0] = zero16(); o[1] = zero16();
            bf16x8 f0[4], f1[4], f2[4];
#define SB_ __builtin_amdgcn_sched_barrier(0)
#define LDW(kt, s2, f) do { f[0] = lds_frag(fb + R_WN + ((0 * 4 + (kt)) * 2 + (s2)) * 1024); f[1] = lds_frag(fb + R_WN + ((1 * 4 + (kt)) * 2 + (s2)) * 1024); \
                f[2] = lds_frag(fb + R_QG + ((0 * 4 + (kt)) * 2 + (s2)) * 1024); f[3] = lds_frag(fb + R_QG + ((1 * 4 + (kt)) * 2 + (s2)) * 1024); SB_; } while (0)
#define MMW(kt, s2, f) do { const bf16x8 sb_ = (s2) ? pack_hi(S[kt]) : pack_lo(S[kt]); \
                vn[0] = MFMA32(f[0], sb_, vn[0]); vn[1] = MFMA32(f[1], sb_, vn[1]); o[0] = MFMA32(f[2], sb_, o[0]); o[1] = MFMA32(f[3], sb_, o[1]); SB_; } while (0)
#define LDQK(s2, f) do { f[0] = lds_frag(fb + R_QK + ((0 * 2 + 0) * 2 + (s2)) * 1024); f[1] = lds_frag(fb + R_QK + ((1 * 2 + 0) * 2 + (s2)) * 1024); f[2] = lds_frag(fb + R_QK + ((1 * 2 + 1) * 2 + (s2)) * 1024); SB_; } while (0)
#define LDK(it, s2, f) do { _Pragma("unroll") for (int kt_ = 0; kt_ < 4; ++kt_) f[kt_] = lds_frag(fb + R_KGT + ((kt_ * 2 + (it)) * 2 + (s2)) * 1024); SB_; } while (0)
#define MMK(f, vb_) do { _Pragma("unroll") for (int kt_ = 0; kt_ < 4; ++kt_) S[kt_] = MFMA32(f[kt_], vb_, S[kt_]); SB_; } while (0)
            LDW(0, 0, f0); LDW(0, 1, f1);
            LDW(1, 0, f2); MMW(0, 0, f0);
            LDW(1, 1, f0); MMW(0, 1, f1);
            LDW(2, 0, f1); MMW(1, 0, f2);
            LDW(2, 1, f2); MMW(1, 1, f0);
            LDW(3, 0, f0); MMW(2, 0, f1);
            LDW(3, 1, f1); MMW(2, 1, f2);
            LDQK(0, f2);   MMW(3, 0, f0);
            LDQK(1, f0);   MMW(3, 1, f1);
#pragma unroll
            for (int kt = 0; kt < 4; ++kt)
#pragma unroll
                for (int reg = 0; reg < 16; ++reg) S[kt][reg] *= eg;
            const bf16x8 v00 = pack_lo(vn[0]), v01 = pack_hi(vn[0]), v10 = pack_lo(vn[1]), v11 = pack_hi(vn[1]);
            LDK(0, 0, f1);
            o[0] = MFMA32(f2[0], v00, o[0]); o[1] = MFMA32(f2[1], v00, o[1]); o[1] = MFMA32(f2[2], v10, o[1]); SB_;
            LDK(0, 1, f2);
            o[0] = MFMA32(f0[0], v01, o[0]); o[1] = MFMA32(f0[1], v01, o[1]); o[1] = MFMA32(f0[2], v11, o[1]); SB_;
            LDK(1, 0, f0); MMK(f1, v00);
            LDK(1, 1, f1); MMK(f2, v01);
            MMK(f0, v10); MMK(f1, v11);
#undef LDW
#undef MMW
#undef LDQK
#undef LDK
#undef MMK
#undef SB_
            LAS unsigned char* ob = lds + SC_OB + (c & 1) * OB_BYTES + (32 * w + r) * 2;
#pragma unroll
            for (int mt = 0; mt < 2; ++mt)
#pragma unroll
                for (int reg = 0; reg < 16; reg += 2) { const unsigned pw = pk2(o[mt][reg], o[mt][reg + 1]); *(LAS unsigned short*)(ob + (32 * mt + crow(reg, hh)) * (OB_LD * 2)) = (unsigned short)pw; *(LAS unsigned short*)(ob + (32 * mt + crow(reg + 1, hh)) * (OB_LD * 2)) = (unsigned short)(pw >> 16); }
        } else {
            if (c + 1 < 32) SCAN_DMA(c + 1, (c + 1) & 1);
            if (c > 0) scan_finish(F, l, b, h, c - 1, lds + SC_OB + ((c - 1) & 1) * OB_BYTES, pf, t4);
#pragma unroll
            for (int q = 0; q < 4; ++q) pf[q] = *(const v4u*)(zbase + (size_t)(64 * c) * DM + q * 8);
        }
    }
#undef SCAN_DMA
    asm volatile("s_waitcnt vmcnt(0)" ::: "memory");
    __syncthreads();
    if (w < 4) {
        float* so = F.out + O_SDP + (((size_t)l * NB + b) * NH + h) * HD * HD + 32 * w + r;
#pragma unroll
        for (int kt = 0; kt < 4; ++kt)
#pragma unroll
            for (int reg = 0; reg < 16; ++reg) so[(size_t)(32 * kt + crow(reg, hh)) * HD] = S[kt][reg];
    } else scan_finish(F, l, b, h, 31, lds + SC_OB + (31 & 1) * OB_BYTES, pf, t4);
    __syncthreads();
}

DI void d_units_sample4(Frame& F, int l, int ubase) {
    const int w = F.wave, lane = F.lane, unit = ubase + (w >> 1), half = w & 1, seq = unit >> 3, h = unit & 7;
    const bf16* qc = (const bf16*)(F.ws + WS_QKVS); const float* ab = (const float*)(F.ws + WS_AB);
    const int row0 = TP + seq * TS_, dv = half * 64 + lane;
    LAS unsigned char* wl = F.lds + w * 8192;
    LAS unsigned char* ol = F.lds + 65536 + (w >> 1) * 4096;
    { const int t = lane >> 3, part = (lane >> 2) & 1, ch = lane & 3; const v4u* src = (const v4u*)(qc + (size_t)(row0 - TP + t) * DCONV + part * 1024 + h * HD + ch * 32);
      LAS f32x4* dst = (LAS f32x4*)(wl + t * 1024 + part * 512 + ch * 128);
#pragma unroll
      for (int q = 0; q < 4; ++q) { const v4u a = src[q]; dst[2 * q] = (f32x4){bflo(a.x), bfhi(a.x), bflo(a.y), bfhi(a.y)}; dst[2 * q + 1] = (f32x4){bflo(a.z), bfhi(a.z), bflo(a.w), bfhi(a.w)}; } }
    float gt[8], bt[8], vv[8];
#pragma unroll
    for (int t = 0; t < 8; ++t) { gt[t] = ab[(size_t)(row0 + t) * 16 + h]; bt[t] = ab[(size_t)(row0 + t) * 16 + 8 + h]; vv[t] = pg8::bf2f(qc[(size_t)(row0 - TP + t) * DCONV + 2048 + h * HD + dv]); }
    {
        f32x2_ S[64];
        { const float* s0 = F.in[2] + (((size_t)l * NS + seq) * NH + h) * HD * HD + dv;
#pragma unroll
          for (int k = 0; k < 64; ++k) { S[k].x = s0[(size_t)(2 * k) * HD]; S[k].y = s0[(size_t)(2 * k + 1) * HD]; } }
#pragma unroll 1
        for (int t = 0; t < TS_; ++t) {
            float g = gt[0], beta = bt[0], vt = vv[0];
#pragma unroll
            for (int i = 1; i < 8; ++i) { if (t == i) { g = gt[i]; beta = bt[i]; vt = vv[i]; } }
            const float e = __expf(g);
            const LAS f32x4* kp = (const LAS f32x4*)(wl + t * 1024 + 512); const LAS f32x4* qp = (const LAS f32x4*)(wl + t * 1024);
            f32x2_ ks2 = (f32x2_){0.f, 0.f};
#pragma unroll
            for (int c = 0; c < 32; ++c) { const f32x4 kw = kp[c]; ks2 = ks2 + (f32x2_){kw.x, kw.y} * S[2 * c]; ks2 = ks2 + (f32x2_){kw.z, kw.w} * S[2 * c + 1];
                if ((c & 7) == 7) asm volatile("" ::: "memory"); }
            const float dlt = beta * (vt - e * (ks2.x + ks2.y));
            f32x2_ o2 = (f32x2_){0.f, 0.f};
#pragma unroll
            for (int c = 0; c < 32; ++c) { const f32x4 kw = kp[c], qw = qp[c];
                S[2 * c] = S[2 * c] * e + (f32x2_){kw.x, kw.y} * dlt; o2 = o2 + (f32x2_){qw.x, qw.y} * S[2 * c];
                S[2 * c + 1] = S[2 * c + 1] * e + (f32x2_){kw.z, kw.w} * dlt; o2 = o2 + (f32x2_){qw.z, qw.w} * S[2 * c + 1];
                if ((c & 3) == 3) asm volatile("" ::: "memory"); }
            *(LAS float*)(ol + (t * 128 + dv) * 4) = o2.x + o2.y;
        }
        float* so = F.out + O_SDS + (((size_t)l * NS + seq) * NH + h) * HD * HD + dv;
#pragma unroll
        for (int k = 0; k < 64; ++k) { so[(size_t)(2 * k) * HD] = S[k].x; so[(size_t)(2 * k + 1) * HD] = S[k].y; }
    }
    __syncthreads();
    const bf16* z = (const bf16*)(F.ws + WS_Z); bf16* oab = (bf16*)(F.ws + WS_OAB); const float* dnw = F.in[9] + l * HD;
    const float w0 = dnw[2 * lane], w1 = dnw[2 * lane + 1];
    f32x2_ ov[4]; float ss[4]; unsigned zw[4];
#pragma unroll
    for (int k = 0; k < 4; ++k) { const int t = 4 * half + k; ov[k] = *(const LAS f32x2_*)(ol + (t * 128 + 2 * lane) * 4); ss[k] = ov[k].x * ov[k].x + ov[k].y * ov[k].y; zw[k] = *(const unsigned*)(z + (size_t)(row0 + t) * DM + h * HD + 2 * lane); }
    wave_sum_n<4>(ss);
#pragma unroll
    for (int k = 0; k < 4; ++k) { const int t = 4 * half + k; const float rs = rsq_(ss[k] * (1.0f / HD) + 1e-6f);
        *(unsigned*)(oab + (size_t)(row0 + t) * LD_OAB + h * HD + 2 * lane) = pk2(ov[k].x * rs * w0 * siluf_(bflo(zw[k])), ov[k].y * rs * w1 * siluf_(bfhi(zw[k]))); }
    __syncthreads();
}
constexpr int CL_ST = 0, CL_VT = 1024, VT_LD = 136, CL_MX = 1024 + 128 * 136 * 2, MX_LD = 132;
DI void cmlp_unit(Frame& F, int l, int ck) {
    const int w = F.wave, lane = F.lane, row0 = 128 * ck;
    LAS unsigned char* lds = F.lds;
    const bf16* uv = (const bf16*)(F.ws + WS_UV); bf16* oab = (bf16*)(F.ws + WS_OAB);
    const float* lw = F.in[10] + l * DB; const float* lb = F.in[11] + l * DB; const float* bsp = F.in[13] + (size_t)l * NH * 128;
    const bf16* wsp = (const bf16*)(F.ws + WS_W + (size_t)l * W_LAYER + W_SP);
    const bool lastck = (ck & 15) == 15;
#pragma unroll 1
    for (int rb = 0; rb < 4; ++rb) {
        f32x4 v[4][4]; float sm[4], sq[4];
#pragma unroll
        for (int k = 0; k < 4; ++k) { const int row = row0 + 16 * w + 4 * rb + k; sm[k] = 0.f;
#pragma unroll
            for (int j = 0; j < 4; ++j) { const v2u u = *((const v2u*)(uv + (size_t)row * 2048 + 1024) + lane + 64 * j); v[k][j] = (f32x4){bflo(u.x), bfhi(u.x), bflo(u.y), bfhi(u.y)}; sm[k] += (v[k][j].x + v[k][j].y) + (v[k][j].z + v[k][j].w); } }
        wave_sum_n<4>(sm);
#pragma unroll
        for (int k = 0; k < 4; ++k) { const float mean = sm[k] * (1.0f / DB); sm[k] = mean; sq[k] = 0.f;
#pragma unroll
            for (int j = 0; j < 4; ++j) { v[k][j] = v[k][j] - mean; sq[k] += (v[k][j].x * v[k][j].x + v[k][j].y * v[k][j].y) + (v[k][j].z * v[k][j].z + v[k][j].w * v[k][j].w); } }
        wave_sum_n<4>(sq);
#pragma unroll
        for (int k = 0; k < 4; ++k) { const int i = 16 * w + 4 * rb + k; const float rstd = rsq_(sq[k] * (1.0f / DB) + 1e-5f);
            if (lane == 0) { ((LAS float*)(lds + CL_ST))[2 * i] = sm[k]; ((LAS float*)(lds + CL_ST))[2 * i + 1] = rstd; }
            if (lastck) { float* cvo = F.out + O_CVP + (((size_t)l * NB + (ck >> 4)) * 128 + i) * DB;
#pragma unroll
                for (int j = 0; j < 4; ++j) { const f32x4 ww = ((const f32x4*)lw)[lane + 64 * j], bb = ((const f32x4*)lb)[lane + 64 * j]; ((f32x4*)cvo)[lane + 64 * j] = v[k][j] * rstd * ww + bb; } } }
    }
    __syncthreads();
    const int r = lane & 31, hh = lane >> 5, nt = w & 3, mta = (w >> 2) ? 1 : 0, mtb = 3 - mta;
    const int erow = F.tid >> 2, eseg = F.tid & 3;
    unsigned va[8], vb[8];
#define CMLP_VLOAD(g_) do { const int ch_ = (g_) * 128 + 2 * lane; _Pragma("unroll") for (int pr = 0; pr < 8; ++pr) { const int j_ = 16 * w + 2 * pr; \
        va[pr] = *(const unsigned*)(uv + (size_t)(row0 + j_) * 2048 + 1024 + ch_); vb[pr] = *(const unsigned*)(uv + (size_t)(row0 + j_ + 1) * 2048 + 1024 + ch_); } } while (0)
    CMLP_VLOAD(0);
#pragma unroll 1
    for (int g = 0; g < 8; ++g) {
        const bf16* wg = wsp + (size_t)g * 128 * 128;
        bf16x8 wa[4], wb[8];
#pragma unroll
        for (int ks = 0; ks < 4; ++ks) wa[ks] = *(const bf16x8*)(wg + (size_t)(32 * mta + r) * 128 + 16 * ks + 8 * hh);
#pragma unroll
        for (int ks = 0; ks < 8; ++ks) wb[ks] = *(const bf16x8*)(wg + (size_t)(32 * mtb + r) * 128 + 16 * ks + 8 * hh);
        const size_t eoff = (size_t)(row0 + erow) * 2048 + g * 128 + eseg * 32;
        v4u uu[4];
#pragma unroll
        for (int q = 0; q < 4; ++q) uu[q] = *(const v4u*)(uv + eoff + q * 8);
        { const int ch = g * 128 + 2 * lane; const float w0 = lw[ch], w1 = lw[ch + 1], b0 = lb[ch], b1 = lb[ch + 1];
#pragma unroll
          for (int pr = 0; pr < 8; ++pr) { const int j = 16 * w + 2 * pr; const unsigned ua = va[pr], ub = vb[pr];
            const f32x4 st = *(const LAS f32x4*)(lds + CL_ST + j * 8);
            const float a0 = (bflo(ua) - st.x) * st.y * w0 + b0, a1 = (bfhi(ua) - st.x) * st.y * w1 + b1, c0 = (bflo(ub) - st.z) * st.w * w0 + b0, c1 = (bfhi(ub) - st.z) * st.w * w1 + b1;
            *(LAS unsigned*)(lds + CL_VT + ((2 * lane) * VT_LD + j) * 2) = pk2(a0, c0);
            *(LAS unsigned*)(lds + CL_VT + ((2 * lane + 1) * VT_LD + j) * 2) = pk2(a1, c1); } }
        if (g + 1 < 8) CMLP_VLOAD(g + 1);
        __syncthreads();
        f32x16 acc[2]; acc[0] = zero16(); acc[1] = zero16();
#pragma unroll
        for (int ks = 0; ks < 8; ++ks) {
            const bf16x8 bfr = lds_frag(lds + CL_VT + ((32 * nt + r) * VT_LD + 16 * ks + 8 * hh) * 2);
            if (ks < 4) acc[0] = MFMA32(wa[ks], bfr, acc[0]);
            acc[1] = MFMA32(wb[ks], bfr, acc[1]);
        }
#pragma unroll
        for (int t2 = 0; t2 < 2; ++t2) { const int mt = t2 ? mtb : mta;
#pragma unroll
            for (int reg = 0; reg < 16; ++reg) { const int i = 32 * mt + crow(reg, hh); *(LAS float*)(lds + CL_MX + (i * MX_LD + 32 * nt + r) * 4) = acc[t2][reg] + bsp[g * 128 + i]; } }
        __syncthreads();
#pragma unroll
        for (int q = 0; q < 4; ++q) { const f32x4 m0 = *(const LAS f32x4*)(lds + CL_MX + (erow * MX_LD + eseg * 32 + q * 8) * 4), m1 = *(const LAS f32x4*)(lds + CL_MX + (erow * MX_LD + eseg * 32 + q * 8 + 4) * 4);
            v4u o; o.x = pk2(bflo(uu[q].x) * m0.x, bfhi(uu[q].x) * m0.y); o.y = pk2(bflo(uu[q].y) * m0.z, bfhi(uu[q].y) * m0.w); o.z = pk2(bflo(uu[q].z) * m1.x, bfhi(uu[q].z) * m1.y); o.w = pk2(bflo(uu[q].w) * m1.z, bfhi(uu[q].w) * m1.w);
            *(v4u*)(oab + (size_t)(row0 + erow) * LD_OAB + 1024 + g * 128 + eseg * 32 + q * 8) = o; }
    }
#undef CMLP_VLOAD
    __syncthreads();
}
DI void cmlp_sample_unit(Frame& F, int l, int n, int jq) {
    const int lane = F.lane, row0 = TP + n * TS_;
    const bf16* uv = (const bf16*)(F.ws + WS_UV); bf16* oab = (bf16*)(F.ws + WS_OAB);
    const float* lw = F.in[10] + l * DB; const float* lb = F.in[11] + l * DB; const float* bsp = F.in[13] + (size_t)l * NH * 128; const float* wsp = F.in[12] + (size_t)l * NH * 128 * 128;
    v2u raw[8][4];
#pragma unroll
    for (int t = 0; t < 8; ++t)
#pragma unroll
        for (int j = 0; j < 4; ++j) raw[t][j] = *((const v2u*)(uv + (size_t)(row0 + t) * 2048 + 1024) + lane + 64 * j);
    v2u uu[8];
#pragma unroll
    for (int t = 0; t < 8; ++t) uu[t] = *(const v2u*)(uv + (size_t)(row0 + t) * 2048 + 4 * lane + 256 * jq);
    const int g = 2 * jq + (lane >> 5);
    float wm[8][8];
#pragma unroll
    for (int i = 0; i < 8; ++i)
#pragma unroll
        for (int jj = 0; jj <= i; ++jj) wm[i][jj] = wsp[((size_t)g * 128 + i) * 128 + jj];
    float sm[8], sq[8];
#pragma unroll
    for (int t = 0; t < 8; ++t) { sm[t] = 0.f;
#pragma unroll
        for (int j = 0; j < 4; ++j) sm[t] += (bflo(raw[t][j].x) + bfhi(raw[t][j].x)) + (bflo(raw[t][j].y) + bfhi(raw[t][j].y)); }
    wave_sum_n<8>(sm);
#pragma unroll
    for (int t = 0; t < 8; ++t) { const float mean = sm[t] * (1.0f / DB); sm[t] = mean; sq[t] = 0.f;
#pragma unroll
        for (int j = 0; j < 4; ++j) { const float a = bflo(raw[t][j].x) - mean, b2 = bfhi(raw[t][j].x) - mean, c = bflo(raw[t][j].y) - mean, d = bfhi(raw[t][j].y) - mean; sq[t] += (a * a + b2 * b2) + (c * c + d * d); } }
    wave_sum_n<8>(sq);
    const f32x4 ww = ((const f32x4*)lw)[lane + 64 * jq], bb = ((const f32x4*)lb)[lane + 64 * jq];
    f32x4 vn[8];
#pragma unroll
    for (int t = 0; t < 8; ++t) { const float rstd = rsq_(sq[t] * (1.0f / DB) + 1e-5f), mean = sm[t];
        f32x4 v;
        if (jq == 0) v = (f32x4){bflo(raw[t][0].x), bfhi(raw[t][0].x), bflo(raw[t][0].y), bfhi(raw[t][0].y)};
        else if (jq == 1) v = (f32x4){bflo(raw[t][1].x), bfhi(raw[t][1].x), bflo(raw[t][1].y), bfhi(raw[t][1].y)};
        else if (jq == 2) v = (f32x4){bflo(raw[t][2].x), bfhi(raw[t][2].x), bflo(raw[t][2].y), bfhi(raw[t][2].y)};
        else v = (f32x4){bflo(raw[t][3].x), bfhi(raw[t][3].x), bflo(raw[t][3].y), bfhi(raw[t][3].y)};
        vn[t] = (v - mean) * rstd * ww + bb;
        ((f32x4*)(F.out + O_CVS + (((size_t)l * NS + n) * TS_ + t) * DB))[lane + 64 * jq] = vn[t]; }
#pragma unroll
    for (int i = 0; i < 8; ++i) { f32x4 m = (f32x4){0.f, 0.f, 0.f, 0.f};
#pragma unroll
        for (int jj = 0; jj <= i; ++jj) m = m + vn[jj] * wm[i][jj];
        m = m + bsp[g * 128 + i];
        v2u o; o.x = pk2(bflo(uu[i].x) * m.x, bfhi(uu[i].x) * m.y); o.y = pk2(bflo(uu[i].y) * m.z, bfhi(uu[i].y) * m.w);
        *(v2u*)(oab + (size_t)(row0 + i) * LD_OAB + 1024 + 4 * lane + 256 * jq) = o; }
}
DI void d_phase(Frame& F, int l) {
    constexpr int NU = NS * NH, U_SB = 512;
    if (F.bid < NB * NH) { scan_unit(F, l, F.bid); return; }
    if (F.bid < NB * NH + 128) { const int cb = F.bid - NB * NH; cmlp_unit(F, l, cb);
        for (int ub = U_SB + 4 * cb; ub < NU; ub += 4 * 128) d_units_sample4(F, l, ub);
        if (l == 0) tr_range(F, I_L, I_L + WT_CM, cb * NWAVES + F.wave, 128 * NWAVES);
        return; }
    const int sb = F.bid - NB * NH - 128, nsb = F.G - NB * NH - 128;
    for (int ub = 4 * sb; ub < U_SB; ub += 4 * nsb) d_units_sample4(F, l, ub);
    const int gw = sb * NWAVES + F.wave, NGW = nsb * NWAVES;
    for (int u = gw; u < NS * 4; u += NGW) cmlp_sample_unit(F, l, u >> 2, u & 3);
    if (l == 0) { __syncthreads(); tr_range(F, I_L + WT_CM, 2 * I_L, gw, NGW); }
}
typedef float f32x4_ __attribute__((ext_vector_type(4)));
DI void tail_gemm(Frame& F, int kind, const bf16* A, const bf16* Bt, int K, int lda, int ldb) {
    const int w = F.wave, lane = F.lane, t = F.bid, idx = t >> 4, sub = t & 15;
    const int row0 = TP + 256 * (idx >> 2) + 64 * (sub >> 2), col0 = 256 * (idx & 3) + 64 * (sub & 3);
    const int kw = K >> 3, nks = kw >> 5, l15 = lane & 15, lq = lane >> 4;
    const bf16* ap = A + (size_t)(row0 + l15) * lda + w * kw + 8 * lq;
    const bf16* bp = Bt + (size_t)(col0 + l15) * ldb + w * kw + 8 * lq;
    f32x4_ acc[4][4];
#pragma unroll
    for (int mi = 0; mi < 4; ++mi)
#pragma unroll
        for (int ni = 0; ni < 4; ++ni) acc[mi][ni] = (f32x4_){0.f, 0.f, 0.f, 0.f};
#pragma unroll 1
    for (int k0 = 0; k0 < nks; k0 += 4) {
        bf16x8 fa[4][4], fb[4][4];
#pragma unroll
        for (int kk = 0; kk < 4; ++kk) { const int ko = (k0 + kk < nks) ? 32 * (k0 + kk) : 0;
#pragma unroll
            for (int q = 0; q < 4; ++q) { fa[kk][q] = *(const bf16x8*)(ap + (size_t)(16 * q) * lda + ko); fb[kk][q] = *(const bf16x8*)(bp + (size_t)(16 * q) * ldb + ko); } }
#pragma unroll
        for (int kk = 0; kk < 4; ++kk) { if (k0 + kk < nks) {
#pragma unroll
            for (int mi = 0; mi < 4; ++mi)
#pragma unroll
                for (int ni = 0; ni < 4; ++ni) acc[mi][ni] = __builtin_amdgcn_mfma_f32_16x16x32_bf16(fa[kk][mi], fb[kk][ni], acc[mi][ni], 0, 0, 0); } }
    }
    LAS float* pl = (LAS float*)(F.lds + w * 16384);
#pragma unroll
    for (int mi = 0; mi < 4; ++mi)
#pragma unroll
        for (int ni = 0; ni < 4; ++ni)
#pragma unroll
            for (int rg = 0; rg < 4; ++rg) pl[(16 * mi + 4 * lq + rg) * 64 + 16 * ni + l15] = acc[mi][ni][rg];
    __syncthreads();
    const int er = F.tid >> 3, ec = (F.tid & 7) * 8;
    f32x4_ s0[2], s1[2]; s0[0] = s0[1] = s1[0] = s1[1] = (f32x4_){0.f, 0.f, 0.f, 0.f};
#pragma unroll
    for (int ww = 0; ww < 8; ++ww) { const LAS f32x4_* p = (const LAS f32x4_*)(F.lds + ww * 16384 + (er * 64 + ec) * 4);
        if (ww < 4) { s0[0] = s0[0] + p[0]; s0[1] = s0[1] + p[1]; } else { s1[0] = s1[0] + p[0]; s1[1] = s1[1] + p[1]; } }
    float o[8];
    if (kind == 1) {
        const bf16* gt = (const bf16*)(F.ws + WS_GT) + (size_t)(row0 + er) * 2048 + col0 + ec;
        const v4u gaw = *(const v4u*)gt, gbw = *(const v4u*)(gt + 1024);
#pragma unroll
        for (int e = 0; e < 4; ++e) { const float a0 = bflo(gaw[e]), a1 = bfhi(gaw[e]), b0 = bflo(gbw[e]), b1 = bfhi(gbw[e]);
            o[2 * e] = sigmoidf_(a0) * s0[e >> 1][(2 * e) & 3] + sigmoidf_(b0) * s1[e >> 1][(2 * e) & 3];
            o[2 * e + 1] = sigmoidf_(a1) * s0[e >> 1][(2 * e + 1) & 3] + sigmoidf_(b1) * s1[e >> 1][(2 * e + 1) & 3]; }
    } else {
#pragma unroll
        for (int e = 0; e < 8; ++e) o[e] = s0[e >> 2][e & 3] + s1[e >> 2][e & 3];
    }
    bf16* dst = (bf16*)(F.ws + (kind == 1 ? WS_MERGED : WS_Y)) + (size_t)(row0 + er) * DM + col0 + ec;
    *(v4u*)dst = (v4u){pk2(o[0], o[1]), pk2(o[2], o[3]), pk2(o[4], o[5]), pk2(o[6], o[7])};
    __syncthreads();
}

#define XB_TMO      128
#define XB_XCNT(j)  (256  + 64 * (j))
#define XB_XSUB(j)  (1280 + 64 * (j))
#define XB_XGEN(j)  (2304 + 64 * (j))
#define XB_TOP      3328
#define XB_TOPGEN   3392
#define XCD_BAR_WORDS 3456
#define XB_SPIN_CAP (1u << 22)
__device__ __forceinline__ unsigned xb_ld(unsigned* p)              { return __hip_atomic_load(p, __ATOMIC_RELAXED, __HIP_MEMORY_SCOPE_AGENT); }
__device__ __forceinline__ unsigned xb_add(unsigned* p, unsigned v) { return __hip_atomic_fetch_add(p, v, __ATOMIC_RELAXED, __HIP_MEMORY_SCOPE_AGENT); }
__device__ __forceinline__ unsigned xb_xcc_id() { return (unsigned)__builtin_amdgcn_s_getreg((3 << 11) | 20) & 0xFu; }
#define XB_SPIN(cond, bar) do { unsigned _sp = 0; while (cond) { __builtin_amdgcn_s_sleep(1); \
    if ((++_sp & 255u) == 0u) { if (xb_ld(&(bar)[XB_TMO])) break; if (_sp > XB_SPIN_CAP) { atomicAdd(&(bar)[XB_TMO], 1u); break; } } } } while (0)
struct XcdBarrier { unsigned* bar; unsigned x; volatile LAS unsigned* st; };
__device__ __forceinline__ XcdBarrier xcd_barrier_post(unsigned* bar, volatile LAS unsigned* st) {
    XcdBarrier b; b.bar = bar; b.x = xb_xcc_id(); b.st = st;
    if (threadIdx.x == 0) (void)xb_add(&bar[XB_XCNT(b.x)], 1u);
    return b;
}
__device__ __forceinline__ void xcd_barrier_complete(unsigned* bar, unsigned x, unsigned& nloc, unsigned& nx) {
    const unsigned G = gridDim.x * gridDim.y * gridDim.z;
    unsigned sum, cnt, mine, sp = 0u;
    for (;;) {
        sum = 0u; cnt = 0u; mine = 0u;
#pragma unroll 1
        for (unsigned j = 0; j < 16; ++j) { const unsigned c = xb_ld(&bar[XB_XCNT(j)]); sum += c; cnt += (c > 0u) ? 1u : 0u; mine = (j == x) ? c : mine; }
        if (sum == G) break;
        __builtin_amdgcn_s_sleep(1);
        if ((++sp & 255u) == 0u) { if (xb_ld(&bar[XB_TMO])) break; if (sp > XB_SPIN_CAP) { atomicAdd(&bar[XB_TMO], 1u); break; } }
    }
    nloc = mine > 0u ? mine : 1u; nx = cnt > 0u ? cnt : 1u;
}
__device__ __forceinline__ void xcd_barrier(const XcdBarrier& b) {
    asm volatile("s_waitcnt vmcnt(0)" ::: "memory");
    __syncthreads();
    if (threadIdx.x == 0) {
        unsigned* bar = b.bar; asm volatile("" : "+s"(bar));
        __builtin_amdgcn_s_waitcnt(0);
        unsigned nloc = b.st[0], nx = b.st[1];
        if (nloc == 0u) { xcd_barrier_complete(bar, b.x, nloc, nx); b.st[0] = nloc; b.st[1] = nx; }
        const unsigned old = xb_add(&bar[XB_XSUB(b.x)], 1u);
        const unsigned gen = old / nloc;
        if (old + 1u == (gen + 1u) * nloc) {
            __builtin_amdgcn_fence(__ATOMIC_RELEASE, "agent");
            asm volatile("s_waitcnt vmcnt(0)" ::: "memory");
            const unsigned og = xb_add(&bar[XB_TOP], 1u);
            const unsigned tg = og / nx;
            if (og + 1u == (tg + 1u) * nx) xb_add(&bar[XB_TOPGEN], 1u);
            else XB_SPIN(xb_ld(&bar[XB_TOPGEN]) == tg, bar);
            __builtin_amdgcn_fence(__ATOMIC_ACQUIRE, "agent");
            xb_add(&bar[XB_XGEN(b.x)], 1u);
            asm volatile("s_waitcnt vmcnt(0)" ::: "memory");
        } else {
            XB_SPIN(xb_ld(&bar[XB_XGEN(b.x)]) == gen, bar);
            __builtin_amdgcn_fence(__ATOMIC_ACQUIRE, "agent");
            asm volatile("s_waitcnt vmcnt(0)" ::: "memory");
        }
    }
    __syncthreads();
}

constexpr int PH_PER_LAYER = 9, N_PHASES = 1 + DEPTH * PH_PER_LAYER;
__global__ void __launch_bounds__(NWAVES * 64, 2) mega_fwd(Args args) {
    extern __shared__ __attribute__((aligned(16))) unsigned char lds_raw[];
    Frame F; F.lds = (LAS unsigned char*)lds_raw; F.tid = threadIdx.x; F.lane = F.tid & 63; F.wave = __builtin_amdgcn_readfirstlane(F.tid >> 6);
    F.G = gridDim.x; F.bid = blockIdx.x; F.out = args.out; F.ws = args.ws;
#if MK_ONE_LAUNCH
    if (threadIdx.x < 16) ((LAS unsigned*)(F.lds + LDS_BYTES - 64))[threadIdx.x] = 0u;
    __syncthreads();
    const XcdBarrier xbar = xcd_barrier_post((unsigned*)(args.ws + WS_CTL) + 4096, (volatile LAS unsigned*)(F.lds + LDS_BYTES - 64));
#define SEAM(k) do { if ((k) + 1 < hi) xcd_barrier(xbar); } while (0)
#else
#define SEAM(k) do { } while (0)
#endif
#ifndef PH_MASK
#define PH_MASK 0x7ff
#endif
#define EN(j) ((PH_MASK >> (j)) & 1)
    int lo = args.ph_lo; const int hi = args.ph_hi;
    unsigned char* ws = args.ws;
    if (lo == 0) {
        { __attribute__((address_space(1))) unsigned char* w_ = (__attribute__((address_space(1))) unsigned char*)args.ws; asm volatile("" : "+s"(w_)); F.ws = (unsigned char*)w_; }
        if (EN(10)) { p0_weights(F); p0_rows(F); }
#if MK_ONE_LAUNCH
        if (hi > 1) cg::this_grid().sync();
#endif
        lo = 1;
    }
#pragma unroll 1
    for (int p = lo; p < hi; ++p) {
        { __attribute__((address_space(1))) unsigned char* w_ = (__attribute__((address_space(1))) unsigned char*)args.ws; __attribute__((address_space(1))) float* o_ = (__attribute__((address_space(1))) float*)args.out;
          int t_ = threadIdx.x; asm volatile("" : "+s"(w_), "+s"(o_), "+v"(t_)); ws = (unsigned char*)w_; F.ws = (unsigned char*)w_; F.out = (float*)o_;
          F.tid = t_; F.lane = t_ & 63; F.wave = __builtin_amdgcn_readfirstlane(t_ >> 6); }
        {
            const int l = (p - 1) / PH_PER_LAYER, j = (p - 1) % PH_PER_LAYER;
            int gk = -1;
#define REOPQ() do { __attribute__((address_space(1))) unsigned char* w__ = (__attribute__((address_space(1))) unsigned char*)args.ws; asm volatile("" : "+s"(w__)); F.ws = (unsigned char*)w__; ws = (unsigned char*)w__; } while (0)
            if (j == 0 || j == 3 || j == 4 || j == 6 || j == 7) gk = j;
            else if (j == 1) { REOPQ(); if (EN(1)) prep_phase(F, l); }
            else if (j == 2) { REOPQ(); if (EN(2)) d_phase(F, l); }
            else if (EN(5)) { REOPQ(); const bool r1 = (j == 5); rows_residual(F, (const bf16*)(ws + WS_Y), (r1 ? F.in[17] : F.in[21]) + l * DM, r1 && l == 0, !r1 && l == DEPTH - 1, r1 ? -1 : l + 1); }
            if (EN(0) && gk >= 0) {
                REOPQ(); unsigned char* wl = ws + WS_W + (size_t)l * W_LAYER;
                pg8::Gemm g; pg8::EpiAny E; E.mid_t = -1; E.ws = ws;
                if (gk == 0)      { g = pg8::Gemm{(const bf16*)(ws + WS_XB), (const bf16*)(wl + W_IN), TT, 8192, DM, DM, DM}; E.kind = 0; }
                else if (gk == 3) { g = pg8::Gemm{(const bf16*)(ws + WS_OAB), (const bf16*)(wl + W_PAB), TT, DM, 2048, LD_OAB, LD_PAB}; E.kind = 1; E.mid_t = 16; }
                else if (gk == 4) { g = pg8::Gemm{(const bf16*)(ws + WS_MERGED), (const bf16*)(wl + W_OUT), TT, DM, DM, DM, DM}; E.kind = 2; }
                else if (gk == 6) { g = pg8::Gemm{(const bf16*)(ws + WS_XB), (const bf16*)(wl + W_FIN), TT, 2 * DFF, DM, DM, DM}; E.kind = 3; }
                else              { g = pg8::Gemm{(const bf16*)(ws + WS_H), (const bf16*)(wl + W_FOUT), TT, DM, DFF, DFF, DFF}; E.kind = 2; }
                const bool n1k = (g.N == DM);
                if (n1k) g.M = TP;
                pg8::StaticOrder S; S.init(g.M, g.N, F.G, F.bid); S.pmaj = n1k ? 1 : 0;
                pg8::gemm_phase<pg8::EpiAny, pg8::StaticOrder, true, true>(F.lds, g, S, E);
                if (n1k) tail_gemm(F, E.kind, g.A, g.Bt, g.K, g.lda, g.ldb);
            }
        }
        SEAM(p);
    }
#undef SEAM
}

extern "C" void kernel_launch(void* const* d_in, const int* in_sizes, int n_in, void* d_out, int out_size, void* d_ws, size_t ws_size, hipStream_t stream) {
    static int grid = 0;
    if (grid == 0) {
        if (n_in != 22 || (size_t)out_size != O_END || ws_size < WS_END) { fprintf(stderr, "kernel_launch: unexpected shapes: n_in %d out %d (want %zu) ws %zu (need %zu)\n", n_in, out_size, (size_t)O_END, ws_size, (size_t)WS_END); grid = -1; return; }
        int dev = 0, cus = 0, per_cu = 0;
        if (hipGetDevice(&dev) != hipSuccess || hipDeviceGetAttribute(&cus, hipDeviceAttributeMultiprocessorCount, dev) != hipSuccess) { grid = -1; return; }
        if (hipFuncSetAttribute((const void*)mega_fwd, hipFuncAttributeMaxDynamicSharedMemorySize, LDS_BYTES) != hipSuccess) { fprintf(stderr, "kernel_launch: hipFuncSetAttribute failed\n"); grid = -1; return; }
        if (hipOccupancyMaxActiveBlocksPerMultiprocessor(&per_cu, (const void*)mega_fwd, NWAVES * 64, LDS_BYTES) != hipSuccess || per_cu < 1) { fprintf(stderr, "kernel_launch: occupancy query says %d\n", per_cu); per_cu = 1; }
        (void)hipGetLastError();
        grid = cus;
        if (grid != 256) { fprintf(stderr, "kernel_launch: this kernel is laid out for a 256-CU device (got %d)\n", grid); grid = -1; return; }
    }
    if (grid < 0) return;
    Args a{};
    for (int i = 0; i < 22; ++i) a.in[i] = (const float*)d_in[i];
    a.out = (float*)d_out; a.ws = (unsigned char*)d_ws;
#if MK_ONE_LAUNCH
    if (hipMemsetAsync((char*)d_ws + WS_CTL, 0, 64 * 1024, stream) != hipSuccess) { fprintf(stderr, "kernel_launch: memset failed\n"); return; }
    a.ph_lo = 0; a.ph_hi = N_PHASES;
    void* kargs[] = {&a};
    hipError_t e = hipLaunchCooperativeKernel((void*)mega_fwd, dim3(grid), dim3(NWAVES * 64), kargs, LDS_BYTES, stream);
    if (e != hipSuccess) fprintf(stderr, "cooperative launch failed: %s (grid %d)\n", hipGetErrorString(e), grid);
#else
    for (int p = 0; p < N_PHASES; ++p) { a.ph_lo = p; a.ph_hi = p + 1; hipLaunchKernelGGL(mega_fwd, dim3(grid), dim3(NWAVES * 64), LDS_BYTES, stream, a); }
#endif
}
```

```cpp
#include <hip/hip_runtime.h>
#include <cstdio>
#include <cstdint>

#ifndef MK_ONE_LAUNCH
#define MK_ONE_LAUNCH 1
#endif

constexpr int NWAVES = 8;
constexpr int DM = 1024, NB = 8, SEQ = 2048, DEPTH = 2, NS = 128, TS_ = 8, NH = 8, HD = 128, DCONV = 3072, DB = 1024, DFF = 2816, DIN = 8208;
constexpr int TP = NB * SEQ, TSM = NS * TS_, TT = TP + TSM;
constexpr size_t O_YP = 0, O_YS = (size_t)TP * DM, O_SDP = O_YS + (size_t)TSM * DM, O_SCP = O_SDP + (size_t)DEPTH * NB * NH * HD * HD,
                 O_CVP = O_SCP + (size_t)DEPTH * NB * 3 * DCONV, O_SDS = O_CVP + (size_t)DEPTH * NB * 128 * DB, O_SCS = O_SDS + (size_t)DEPTH * NS * NH * HD * HD,
                 O_CVS = O_SCS + (size_t)DEPTH * NS * 3 * DCONV, O_END = O_CVS + (size_t)DEPTH * NS * TS_ * DB;
constexpr size_t MiB = 1u << 20;
constexpr int LD_OAB = 2112, LD_PAB = 2112;
constexpr size_t WS_CTL = 0, WS_AB = 1 * MiB, WS_RSTD = 3 * MiB, WS_EG = 3 * MiB + 512 * 1024, WS_W = 4 * MiB, W_LAYER = 41 * MiB;
constexpr size_t W_IN = 0, W_PAB = 17 * MiB, W_OUT = 21 * MiB + 256 * 1024, W_FIN = 23 * MiB + 512 * 1024, W_FOUT = 35 * MiB + 256 * 1024, W_SP = 40 * MiB + 768 * 1024;
constexpr size_t WS_A = 86 * MiB, WS_C = 188 * MiB, WS_D = 222 * MiB, WS_E = 290 * MiB, WS_REC = 358 * MiB, WS_QKVS = 502 * MiB, WS_END = 508 * MiB;
constexpr size_t WS_QKVRAW = WS_A, WS_ORAW = WS_A, WS_H = WS_A, WS_Z = WS_C, WS_MERGED = WS_C, WS_UV = WS_D, WS_Y = WS_D, WS_GT = WS_E, Y2_OFF = 34 * MiB  ,
                 WS_XB = WS_REC, WS_OAB = WS_A;
constexpr int REC_BYTES = 73728, R_WN = 0, R_QG = 16384, R_KGT = 32768, R_QK = 49152, R_U = 57344, REC_FRAG_BYTES = 57344;
constexpr int LDS_BYTES = 163840;

namespace pg8 {
#define PG8_LAS __attribute__((address_space(3)))
typedef unsigned short bf16_t;
typedef short bf16x8 __attribute__((ext_vector_type(8)));
typedef float f32x4 __attribute__((ext_vector_type(4)));
typedef unsigned u32x4 __attribute__((ext_vector_type(4)));
constexpr int BM = 256, BK = 64, HALF = 128, HTB = HALF * BK * 2, STAGE_BYTES = 8 * HTB, NXCD = 8, WGM = 8;

__host__ __device__ __forceinline__ int lds_byte(int r, int c) { const int st = (r >> 4) * 2 + (c >> 5), rr = r & 15, cc = c & 31, ob = rr * 64 + cc * 2; return st * 1024 + (ob ^ (((ob >> 9) & 1) << 5)); }
__host__ __device__ __forceinline__ void stage_rc(int b, int& R, int& C) { const int st = b / 1024, sb = b % 1024, swz = sb ^ (((sb >> 9) & 1) << 5); R = (st >> 1) * 16 + swz / 64; C = (st & 1) * 32 + (swz % 64) / 2; }
__host__ __device__ __forceinline__ int perm32(int rho) { const int n = rho >> 4, i = rho & 15; return 8 * (i >> 2) + 4 * n + (i & 3); }

struct Unit { int pm, pn, qm; };
struct Gemm { const bf16_t* A; const bf16_t* Bt; int M, N, K, lda, ldb; };

struct StaticOrder {
    int nM, nN, nwg, G, c, pmaj;
    __host__ __device__ void init(int M, int N, int G_, int c_) { nM = M / BM; nN = N / BM; nwg = nM * nN; G = G_; c = c_; pmaj = 0; }
    __host__ __device__ bool next(int i, Unit& u) const {
        if (pmaj) {
            if (i > 0 || c >= 256) return false; const int x = c & 7, slot = c >> 3; u.pm = (slot >> 2) * 8 + x; u.pn = slot & 3; u.qm = 15; return true; }
        { const int full = nwg / G, rem = nwg - full * G;
          if (rem > 0 && 2 * rem == G && ((c >> 3) & 1)) { if (i > full) return false; i = (i == 0) ? full : i - 1; } }
        long L = (long)i * G + c; u.qm = 15;
        { const int full = nwg / G, rem = nwg - full * G;
          if (rem > 0 && i == full) {
              if (4 * rem <= G) { if (c >= 4 * rem) return false; L = (long)full * G + (c >> 2); u.qm = 1 << (c & 3); }
              else if (2 * rem <= G) { if (c >= 2 * rem) return false; L = (long)full * G + (c >> 1); u.qm = (c & 1) ? 12 : 3; } } }
        if (L >= nwg) return false;
        int wgid = (int)L; { const int q = nwg / NXCD, r = nwg % NXCD, xcd = wgid % NXCD, off = wgid / NXCD; wgid = (xcd < r ? xcd * (q + 1) : r * (q + 1) + (xcd - r) * q) + off; }
        const int nig = WGM * nN, gid = wgid / nig, fm = gid * WGM, gsz = (nM - fm) < WGM ? (nM - fm) : WGM;
        u.pm = fm + ((wgid % nig) % gsz); u.pn = (wgid % nig) / gsz; return true;
    }
    __device__ __forceinline__ void a_ready(const Unit&) const {}
    __device__ __forceinline__ void done(const Unit&) const {}
};

__device__ __forceinline__ unsigned cvt_pk_bf16(float lo, float hi) { unsigned r; asm volatile("v_cvt_pk_bf16_f32 %0, %1, %2" : "=v"(r) : "v"(lo), "v"(hi)); return r; }
typedef float f32x2 __attribute__((ext_vector_type(2)));
__device__ __forceinline__ f32x2 gelu_pk(f32x2 v) {
    const f32x2 av = __builtin_elementwise_abs(v);
    f32x2 p = av * 5.6212998061e-06f + 5.1055209042e-05f; p = p * av + 3.9686136006e-05f; p = p * av + 3.4227392171e-03f; p = p * av + 2.2076997906e-02f; p = p * av + 5.2075162530e-02f; p = p * av + 1.0442737341e+00f;
    p = p * p; p = p * p; p = p * p; p = p * p;
    f32x2 r; r.x = __builtin_amdgcn_rcpf(p.x); r.y = __builtin_amdgcn_rcpf(p.y);
    f32x2 mx; mx.x = __builtin_fmaxf(v.x, 0.f); mx.y = __builtin_fmaxf(v.y, 0.f);
    return mx - av * r;
}
__device__ __forceinline__ float sigm(float x) { return __builtin_amdgcn_rcpf(1.0f + __expf(-x)); }
__device__ __forceinline__ float bf2f(unsigned short u) { return __uint_as_float((unsigned)u << 16); }


struct EpiProj {
    static constexpr bool PERM = true, AFTER_DRAIN = false; static constexpr int MID_T = 0;
    unsigned char* ws;
    __device__ __forceinline__ void mid(f32x4 (&acc)[2][2][4][2], const Unit& u, int wr, int wc, int fr, int fq) const {}
    __device__ __forceinline__ void operator()(const f32x4 (&acc)[2][2][4][2], const Unit& u, int wr, int wc, int fr, int fq) const {
        const int row0 = u.pm * BM + wr * 64 + fr; const int pn = u.pn;
        bf16_t* base; int ld, colt; bool act = false;
        if (pn < 12) { base = (bf16_t*)(ws + WS_QKVRAW); ld = 3072; colt = pn * BM; }
        else if (pn < 16) { base = (bf16_t*)(ws + WS_Z); ld = 1024; colt = (pn - 12) * BM; }
        else if (pn < 24) { base = (bf16_t*)(ws + WS_UV); ld = 2048; colt = (pn - 16) * BM; act = true; }
        else { base = (bf16_t*)(ws + WS_GT); ld = 2048; colt = (pn - 24) * BM; }
        const int col0 = colt + wc * 32 + 8 * fq;
#pragma unroll
        for (int ai = 0; ai < 2; ++ai)
#pragma unroll
            for (int m = 0; m < 4; ++m) { if (!((u.qm >> (2 * ai)) & 3)) continue; const int row = row0 + ai * HALF + m * 16; bf16_t* rowp = base + (size_t)row * ld + col0;
#pragma unroll
                for (int bj = 0; bj < 2; ++bj) { if (!((u.qm >> (2 * ai + bj)) & 1)) continue; f32x4 v0 = acc[ai][bj][m][0], v1 = acc[ai][bj][m][1];
                    if (act) { f32x2 a = gelu_pk((f32x2){v0[0], v0[1]}), b = gelu_pk((f32x2){v0[2], v0[3]}), c = gelu_pk((f32x2){v1[0], v1[1]}), d = gelu_pk((f32x2){v1[2], v1[3]});
                        v0 = (f32x4){a.x, a.y, b.x, b.y}; v1 = (f32x4){c.x, c.y, d.x, d.y}; }
                    u32x4 w; w.x = cvt_pk_bf16(v0[0], v0[1]); w.y = cvt_pk_bf16(v0[2], v0[3]); w.z = cvt_pk_bf16(v1[0], v1[1]); w.w = cvt_pk_bf16(v1[2], v1[3]);
                    *(u32x4*)(rowp + bj * HALF) = w; } }
    }
};
struct EpiMerge {
    static constexpr bool PERM = true, AFTER_DRAIN = false; static constexpr int MID_T = 16;
    unsigned char* ws;
    __device__ __forceinline__ void mid(f32x4 (&acc)[2][2][4][2], const Unit& u, int wr, int wc, int fr, int fq) const {
        int row0 = u.pm * BM + wr * 64 + fr, col0 = u.pn * BM + wc * 32 + 8 * fq;
        asm volatile("" : "+v"(row0), "+v"(col0));
        const bf16_t* GT = (const bf16_t*)(ws + WS_GT);
#pragma unroll
        for (int ai = 0; ai < 2; ++ai) {
            u32x4 ga[4][2], gb[4][2];
#pragma unroll
            for (int m = 0; m < 4; ++m) { const bf16_t* gp = GT + (size_t)(row0 + ai * HALF + m * 16) * 2048 + col0;
#pragma unroll
                for (int bj = 0; bj < 2; ++bj) { ga[m][bj] = __builtin_nontemporal_load((const u32x4*)(gp + bj * HALF)); gb[m][bj] = *(const u32x4*)(gp + 1024 + bj * HALF); } }
#pragma unroll
            for (int m = 0; m < 4; ++m)
#pragma unroll
                for (int bj = 0; bj < 2; ++bj)
#pragma unroll
                    for (int n = 0; n < 2; ++n)
#pragma unroll
                        for (int e = 0; e < 4; ++e) { const unsigned wa = ga[m][bj][n * 2 + (e >> 1)], wb = gb[m][bj][n * 2 + (e >> 1)];
                            const float a = (e & 1) ? __uint_as_float(wa & 0xffff0000u) : __uint_as_float(wa << 16), b = (e & 1) ? __uint_as_float(wb & 0xffff0000u) : __uint_as_float(wb << 16);
                            acc[ai][bj][m][n][e] *= (1.0f + __expf(-b)) * __builtin_amdgcn_rcpf(1.0f + __expf(-a)); }
            asm volatile("" ::: "memory");
        }
    }
    __device__ __forceinline__ void operator()(const f32x4 (&acc)[2][2][4][2], const Unit& u, int wr, int wc, int fr, int fq) const {
        const int row0 = u.pm * BM + wr * 64 + fr, col0 = u.pn * BM + wc * 32 + 8 * fq; const bf16_t* GT = (const bf16_t*)(ws + WS_GT); bf16_t* O = (bf16_t*)(ws + WS_MERGED);
#pragma unroll
        for (int ai = 0; ai < 2; ++ai) {
            u32x4 gb[4][2];
#pragma unroll
            for (int m = 0; m < 4; ++m)
#pragma unroll
                for (int bj = 0; bj < 2; ++bj) gb[m][bj] = __builtin_nontemporal_load((const u32x4*)(GT + (size_t)(row0 + ai * HALF + m * 16) * 2048 + 1024 + col0 + bj * HALF));
#pragma unroll
            for (int m = 0; m < 4; ++m) { const int row = row0 + ai * HALF + m * 16; bf16_t* rowp = O + (size_t)row * 1024 + col0;
#pragma unroll
                for (int bj = 0; bj < 2; ++bj) { float o[8];
#pragma unroll
                    for (int n = 0; n < 2; ++n)
#pragma unroll
                        for (int e = 0; e < 4; ++e) { const unsigned wb = gb[m][bj][n * 2 + (e >> 1)]; const float b = (e & 1) ? __uint_as_float(wb & 0xffff0000u) : __uint_as_float(wb << 16);
                            o[n * 4 + e] = acc[ai][bj][m][n][e] * sigm(b); }
                    u32x4 w; w.x = cvt_pk_bf16(o[0], o[1]); w.y = cvt_pk_bf16(o[2], o[3]); w.z = cvt_pk_bf16(o[4], o[5]); w.w = cvt_pk_bf16(o[6], o[7]);
                    *(u32x4*)(rowp + bj * HALF) = w; } }
        }
    }
};
struct EpiF32 {
    static constexpr bool PERM = true, AFTER_DRAIN = false; static constexpr int MID_T = 0;
    unsigned char* ws;
    __device__ __forceinline__ void mid(f32x4 (&acc)[2][2][4][2], const Unit& u, int wr, int wc, int fr, int fq) const {}
    __device__ __forceinline__ void operator()(const f32x4 (&acc)[2][2][4][2], const Unit& u, int wr, int wc, int fr, int fq) const {
        const int row0 = u.pm * BM + wr * 64 + fr, col0 = u.pn * BM + wc * 32 + 8 * fq; bf16_t* Y = (bf16_t*)(ws + WS_Y); constexpr int ldc = DM;
#pragma unroll
        for (int ai = 0; ai < 2; ++ai)
#pragma unroll
            for (int m = 0; m < 4; ++m) { if (!((u.qm >> (2 * ai)) & 3)) continue; bf16_t* rowp = Y + (size_t)(row0 + ai * HALF + m * 16) * ldc + col0;
#pragma unroll
                for (int bj = 0; bj < 2; ++bj) { if (!((u.qm >> (2 * ai + bj)) & 1)) continue; const f32x4 v0 = acc[ai][bj][m][0], v1 = acc[ai][bj][m][1];
                    u32x4 w; w.x = cvt_pk_bf16(v0[0], v0[1]); w.y = cvt_pk_bf16(v0[2], v0[3]); w.z = cvt_pk_bf16(v1[0], v1[1]); w.w = cvt_pk_bf16(v1[2], v1[3]);
                    *(u32x4*)(rowp + bj * HALF) = w; } }
    }
};
struct EpiSwiglu {
    static constexpr bool PERM = true, AFTER_DRAIN = false; static constexpr int MID_T = 0;
    unsigned char* ws;
    __device__ __forceinline__ void mid(f32x4 (&acc)[2][2][4][2], const Unit& u, int wr, int wc, int fr, int fq) const {}
    __device__ __forceinline__ void operator()(const f32x4 (&acc)[2][2][4][2], const Unit& u, int wr, int wc, int fr, int fq) const {
        const int row0 = u.pm * BM + wr * 64 + fr, col0 = u.pn * HALF + wc * 32 + 8 * fq; bf16_t* Hh = (bf16_t*)(ws + WS_H); constexpr int ldh = DFF;
#pragma unroll
        for (int ai = 0; ai < 2; ++ai)
#pragma unroll
            for (int m = 0; m < 4; ++m) { if (!((u.qm >> (2 * ai)) & 3)) continue; const int row = row0 + ai * HALF + m * 16; float o[8];
#pragma unroll
                for (int n = 0; n < 2; ++n)
#pragma unroll
                    for (int e = 0; e < 4; ++e) { const float g = acc[ai][0][m][n][e], up = acc[ai][1][m][n][e]; o[n * 4 + e] = g * sigm(g) * up; }
                u32x4 w; w.x = cvt_pk_bf16(o[0], o[1]); w.y = cvt_pk_bf16(o[2], o[3]); w.z = cvt_pk_bf16(o[4], o[5]); w.w = cvt_pk_bf16(o[6], o[7]);
                *(u32x4*)(Hh + (size_t)row * ldh + col0) = w; }
    }
};

struct EpiAny {
    static constexpr bool PERM = true, AFTER_DRAIN = false; static constexpr int MID_T = 1;
    int kind, mid_t;
    unsigned char* ws; size_t yoff;
    __device__ __forceinline__ void mid(f32x4 (&acc)[2][2][4][2], const Unit& u, int wr, int wc, int fr, int fq) const { EpiMerge{ws}.mid(acc, u, wr, wc, fr, fq); }
    __device__ __forceinline__ void operator()(const f32x4 (&acc)[2][2][4][2], const Unit& u, int wr, int wc, int fr, int fq) const {
        if (kind == 0) EpiProj{ws}(acc, u, wr, wc, fr, fq); else if (kind == 1) EpiMerge{ws}(acc, u, wr, wc, fr, fq); else if (kind == 2) EpiF32{ws + yoff}(acc, u, wr, wc, fr, fq); else EpiSwiglu{ws}(acc, u, wr, wc, fr, fq);
    }
};

template <class Epi, class Sched, bool ALIGN_EPI = false, bool SP2 = false>
__device__ __forceinline__ void gemm_phase(PG8_LAS unsigned char* lds, const Gemm g, const Sched& S, const Epi& E) {
    int tid_ = threadIdx.x; asm volatile("" : "+v"(tid_));
    const int tid = tid_, wid = __builtin_amdgcn_readfirstlane(tid >> 6), lane = tid & 63, wr = wid >> 2, wc = wid & 3, fr = lane & 15, fq = lane >> 4;
    const int K = g.K, nt = K / BK;
    unsigned voffA[2], voffB[2];
#pragma unroll
    for (int i = 0; i < 2; ++i) { int R, C; stage_rc(tid * 16 + i * 8192, R, C); const int Rb = Epi::PERM ? ((R & ~31) + perm32(R & 31)) : R;
        voffA[i] = (unsigned)(R * g.lda + C) * 2u; voffB[i] = (unsigned)(Rb * g.ldb + C) * 2u; }
    const size_t kstep = (size_t)(BK * 2);
    const size_t hstepA = (size_t)HALF * g.lda * 2, hstepB = (size_t)HALF * g.ldb * 2;
    const size_t tstepA = 2 * hstepA, tstepB = 2 * hstepB;
    const unsigned ldsw = (unsigned)wid * 1024u;
    const int aoff = lds_byte(wr * 64 + fr, fq * 8), boff = lds_byte(wc * 32 + fr, fq * 8);
#define PG8_SA(b, h) (((b) * 2 + (h)) * HTB)
#define PG8_SB(b, h) ((4 + (b) * 2 + (h)) * HTB)
#define PG8_STAGE(bufoff, gbase, voff) do { _Pragma("unroll") for (int _i = 0; _i < 2; ++_i) \
        __builtin_amdgcn_global_load_lds((const unsigned*)((const char*)(gbase) + (voff)[_i]), (PG8_LAS unsigned*)(lds + (bufoff) + ldsw + _i * 8192), 16, 0, 0); } while (0)
#define PG8_LDA(dst, b, h) do { _Pragma("unroll") for (int m = 0; m < 4; ++m) _Pragma("unroll") for (int k = 0; k < 2; ++k) dst[m][k] = *(const PG8_LAS bf16x8*)(lds + PG8_SA(b, h) + aoff + m * 2048 + k * 1024); } while (0)
#define PG8_LDB(dst, b, h) do { _Pragma("unroll") for (int n = 0; n < 2; ++n) _Pragma("unroll") for (int k = 0; k < 2; ++k) dst[n][k] = *(const PG8_LAS bf16x8*)(lds + PG8_SB(b, h) + boff + n * 2048 + k * 1024); } while (0)
#define PG8_MMA(ai, bj, At, Bt) do { __builtin_amdgcn_s_setprio(1); _Pragma("unroll") for (int m = 0; m < 4; ++m) _Pragma("unroll") for (int n = 0; n < 2; ++n) _Pragma("unroll") for (int k = 0; k < 2; ++k) \
        acc[ai][bj][m][n] = __builtin_amdgcn_mfma_f32_16x16x32_bf16(Bt[n][k], At[m][k], acc[ai][bj][m][n], 0, 0, 0); __builtin_amdgcn_s_setprio(0); } while (0)
#define PG8_WAIT_V(n) asm volatile("s_waitcnt vmcnt(" #n ")" ::: "memory")
#define PG8_WAIT_L(n) asm volatile("s_waitcnt lgkmcnt(" #n ")" ::: "memory")
#define PG8_BAR __builtin_amdgcn_s_barrier()
#define PG8_SCHED __builtin_amdgcn_sched_barrier(0)
    Unit cur, nxt; int ui = 0;
    if (!S.next(0, cur)) return;
    f32x4 acc[2][2][4][2];
#pragma unroll
    for (int a = 0; a < 2; ++a)
#pragma unroll
        for (int b = 0; b < 2; ++b)
#pragma unroll
            for (int m = 0; m < 4; ++m)
#pragma unroll
                for (int n = 0; n < 2; ++n) acc[a][b][m][n] = (f32x4){0.f, 0.f, 0.f, 0.f};
    bf16x8 At[4][2], B0[2][2], B1[2][2];
    const char* cA = (const char*)g.A + (size_t)cur.pm * tstepA; const char* cB = (const char*)g.Bt + (size_t)cur.pn * tstepB;
    S.a_ready(cur);
    if constexpr (SP2) {
        PG8_STAGE(PG8_SB(0, 0), cB, voffB); PG8_STAGE(PG8_SB(0, 1), cB + hstepB, voffB); PG8_STAGE(PG8_SA(0, 0), cA, voffA); PG8_STAGE(PG8_SA(0, 1), cA + hstepA, voffA);
        if (wr == 1) PG8_BAR;
        PG8_WAIT_V(2); PG8_BAR;
        PG8_STAGE(PG8_SB(1, 0), cB + kstep, voffB); PG8_STAGE(PG8_SA(1, 0), cA + kstep, voffA); PG8_STAGE(PG8_SB(1, 1), cB + hstepB + kstep, voffB);
        PG8_WAIT_V(6); PG8_BAR;
    } else {
        PG8_STAGE(PG8_SB(0, 0), cB, voffB); PG8_STAGE(PG8_SA(0, 0), cA, voffA); PG8_STAGE(PG8_SB(0, 1), cB + hstepB, voffB); PG8_STAGE(PG8_SA(0, 1), cA + hstepA, voffA);
        if (wr == 1) PG8_BAR;
        PG8_WAIT_V(4); PG8_BAR;
        PG8_STAGE(PG8_SB(1, 0), cB + kstep, voffB); PG8_STAGE(PG8_SA(1, 0), cA + kstep, voffA); PG8_STAGE(PG8_SB(1, 1), cB + hstepB + kstep, voffB);
        PG8_WAIT_V(6); PG8_BAR;
    }
    for (;;) {
        const bool has_next = S.next(ui + 1, nxt);
        const char* nA = has_next ? (const char*)g.A + (size_t)nxt.pm * tstepA : cA; const char* nB = has_next ? (const char*)g.Bt + (size_t)nxt.pn * tstepB : cB;
        for (int t = 0; t < nt; t += 2) {
            const bool last = (t == nt - 2);
            const char* a1 = cA + (size_t)(t + 1) * kstep;
            const char* a2 = last ? nA : cA + (size_t)(t + 2) * kstep; const char* b2 = last ? nB : cB + (size_t)(t + 2) * kstep;
            const char* a3 = a2 + kstep; const char* b3 = b2 + kstep;
            if (last && has_next) S.a_ready(nxt);
            if constexpr (Epi::MID_T > 0) { if (t == E.mid_t) E.mid(acc, cur, wr, wc, fr, fq); }
            if constexpr (SP2) {
            PG8_LDB(B0, 0, 0); PG8_LDB(B1, 0, 1); PG8_SCHED; PG8_LDA(At, 0, 0); PG8_STAGE(PG8_SA(1, 1), a1 + hstepA, voffA);
            PG8_WAIT_V(8); PG8_WAIT_L(0); PG8_BAR; if (cur.qm & 1) PG8_MMA(0, 0, At, B0); if (cur.qm & 2) PG8_MMA(0, 1, At, B1); PG8_BAR; PG8_SCHED;
            PG8_LDA(At, 0, 1); PG8_STAGE(PG8_SB(0, 0), b2, voffB); PG8_STAGE(PG8_SB(0, 1), b2 + hstepB, voffB); PG8_STAGE(PG8_SA(0, 0), a2, voffA);
            PG8_WAIT_V(8); PG8_WAIT_L(0); PG8_BAR; if (cur.qm & 4) PG8_MMA(1, 0, At, B0); if (cur.qm & 8) PG8_MMA(1, 1, At, B1); PG8_BAR; PG8_SCHED;
            PG8_LDB(B0, 1, 0); PG8_LDB(B1, 1, 1); PG8_SCHED; PG8_LDA(At, 1, 0); PG8_STAGE(PG8_SA(0, 1), a2 + hstepA, voffA);
            PG8_WAIT_V(8); PG8_WAIT_L(0); PG8_BAR; if (cur.qm & 1) PG8_MMA(0, 0, At, B0); if (cur.qm & 2) PG8_MMA(0, 1, At, B1); PG8_BAR; PG8_SCHED;
            PG8_LDA(At, 1, 1); PG8_STAGE(PG8_SB(1, 0), b3, voffB); PG8_STAGE(PG8_SB(1, 1), b3 + hstepB, voffB); PG8_STAGE(PG8_SA(1, 0), a3, voffA);
            PG8_WAIT_V(8); PG8_WAIT_L(0); PG8_BAR; if (cur.qm & 4) PG8_MMA(1, 0, At, B0); if (cur.qm & 8) PG8_MMA(1, 1, At, B1); PG8_BAR; PG8_SCHED;
            } else {
            PG8_LDB(B0, 0, 0); PG8_SCHED; PG8_LDA(At, 0, 0); PG8_STAGE(PG8_SA(1, 1), a1 + hstepA, voffA);
            PG8_WAIT_L(8); PG8_BAR; PG8_WAIT_L(0); PG8_MMA(0, 0, At, B0); PG8_BAR; PG8_SCHED;
            PG8_LDB(B1, 0, 1); PG8_STAGE(PG8_SB(0, 0), b2, voffB);
            PG8_BAR; PG8_WAIT_L(0); PG8_MMA(0, 1, At, B1); PG8_BAR;
            PG8_LDA(At, 0, 1); PG8_STAGE(PG8_SA(0, 0), a2, voffA);
            PG8_BAR; PG8_WAIT_L(0); PG8_MMA(1, 0, At, B0); PG8_BAR; PG8_SCHED;
            PG8_STAGE(PG8_SB(0, 1), b2 + hstepB, voffB);
            PG8_WAIT_V(6); PG8_BAR; PG8_MMA(1, 1, At, B1); PG8_BAR;
            PG8_LDB(B0, 1, 0); PG8_SCHED; PG8_LDA(At, 1, 0); PG8_STAGE(PG8_SA(0, 1), a2 + hstepA, voffA);
            PG8_WAIT_L(8); PG8_BAR; PG8_WAIT_L(0); PG8_MMA(0, 0, At, B0); PG8_BAR; PG8_SCHED;
            PG8_LDB(B1, 1, 1); PG8_STAGE(PG8_SB(1, 0), b3, voffB);
            PG8_BAR; PG8_WAIT_L(0); PG8_MMA(0, 1, At, B1); PG8_BAR;
            PG8_LDA(At, 1, 1); PG8_STAGE(PG8_SA(1, 0), a3, voffA);
            PG8_BAR; PG8_WAIT_L(0); PG8_MMA(1, 0, At, B0); PG8_BAR; PG8_SCHED;
            PG8_STAGE(PG8_SB(1, 1), b3 + hstepB, voffB);
            PG8_WAIT_V(6); PG8_BAR; PG8_MMA(1, 1, At, B1); PG8_BAR;
            }
        }
        if constexpr (ALIGN_EPI) { if (wr == 0) PG8_BAR; }
        if constexpr (!Epi::AFTER_DRAIN) { E(acc, cur, wr, wc, fr, fq); S.done(cur); }
        if (!has_next) break;
#pragma unroll
        for (int a = 0; a < 2; ++a)
#pragma unroll
            for (int b = 0; b < 2; ++b)
#pragma unroll
                for (int m = 0; m < 4; ++m)
#pragma unroll
                    for (int n = 0; n < 2; ++n) acc[a][b][m][n] = (f32x4){0.f, 0.f, 0.f, 0.f};
        cur = nxt; cA = nA; cB = nB; ++ui;
        if constexpr (ALIGN_EPI) { if (wr == 1) PG8_BAR; }
    }
    PG8_WAIT_V(0);
    if constexpr (!ALIGN_EPI) { if (wr == 0) PG8_BAR; }
    PG8_BAR;
#undef PG8_SA
#undef PG8_SB
#undef PG8_STAGE
#undef PG8_LDA
#undef PG8_LDB
#undef PG8_MMA
#undef PG8_WAIT_V
#undef PG8_WAIT_L
#undef PG8_BAR
#undef PG8_SCHED
}
}


#define LAS __attribute__((address_space(3)))
#define DI __device__ __forceinline__
typedef unsigned short bf16;
typedef unsigned v4u __attribute__((ext_vector_type(4)));
typedef unsigned v2u __attribute__((ext_vector_type(2)));
typedef float f32x4 __attribute__((ext_vector_type(4)));
#define LDS_WAIT() asm volatile("s_waitcnt lgkmcnt(0)" ::: "memory")

typedef __bf16 bfv2_ __attribute__((ext_vector_type(2)));
typedef float f32v2_ __attribute__((ext_vector_type(2)));
DI unsigned pk2(float lo, float hi) { return __builtin_bit_cast(unsigned, __builtin_convertvector((f32v2_){lo, hi}, bfv2_)); }
DI unsigned f2bf(float f) { unsigned u = __builtin_bit_cast(unsigned, f); return (u + 0x7fffu + ((u >> 16) & 1u)) >> 16; }
DI unsigned pk2s(float lo, float hi) { return f2bf(lo) | (f2bf(hi) << 16); }
DI float bflo(unsigned w) { return __uint_as_float(w << 16); }
DI float bfhi(unsigned w) { return __uint_as_float(w & 0xffff0000u); }
template <int K> DI float shx(float v) {
    if constexpr (K < 32) return __builtin_bit_cast(float, __builtin_amdgcn_ds_swizzle(__builtin_bit_cast(int, v), (K << 10) | 0x1f));
    else return __shfl_xor(v, 32);
}
DI float wave_sum(float v) {
    v += shx<1>(v); v += shx<2>(v); v += shx<4>(v); v += shx<8>(v); v += shx<16>(v); v += shx<32>(v);
    return v;
}
template <int N, int K> DI void wave_sum_step(float (&v)[N]) { float t[N];
#pragma unroll
    for (int i = 0; i < N; ++i) t[i] = shx<K>(v[i]);
#pragma unroll
    for (int i = 0; i < N; ++i) v[i] += t[i]; }
template <int N> DI void wave_sum_n(float (&v)[N]) {
    wave_sum_step<N, 1>(v); wave_sum_step<N, 2>(v); wave_sum_step<N, 4>(v); wave_sum_step<N, 8>(v); wave_sum_step<N, 16>(v); wave_sum_step<N, 32>(v);
}
DI float wave_sum8t(const float (&v)[8], int lane) {
    const bool b0 = (lane & 1) != 0, b1 = (lane & 2) != 0, b2 = (lane & 4) != 0;
    float a[4], b[2];
#pragma unroll
    for (int k = 0; k < 4; ++k) { const float send = b0 ? v[k] : v[k + 4], keep = b0 ? v[k + 4] : v[k]; a[k] = keep + shx<1>(send); }
#pragma unroll
    for (int k = 0; k < 2; ++k) { const float send = b1 ? a[k] : a[k + 2], keep = b1 ? a[k + 2] : a[k]; b[k] = keep + shx<2>(send); }
    const float send = b2 ? b[0] : b[1], keep = b2 ? b[1] : b[0];
    float c = keep + shx<4>(send);
    c += shx<8>(c); c += shx<16>(c); c += shx<32>(c);
    return c;
}
DI float wave_scan_incl(float v) {
#define DPP_ADD_(ctrl, rmask) v += __builtin_bit_cast(float, __builtin_amdgcn_update_dpp(0, __builtin_bit_cast(int, v), (ctrl), (rmask), 0xf, false))
    DPP_ADD_(0x111, 0xf); DPP_ADD_(0x112, 0xf); DPP_ADD_(0x114, 0xf); DPP_ADD_(0x118, 0xf); DPP_ADD_(0x142, 0xa); DPP_ADD_(0x143, 0xc);
#undef DPP_ADD_
    return v;
}
DI float lane_bcast(float v, int l) { return __builtin_bit_cast(float, __builtin_amdgcn_readlane(__builtin_bit_cast(int, v), l)); }
DI float sigmoidf_(float x) { return __builtin_amdgcn_rcpf(1.0f + __expf(-x)); }
DI float siluf_(float x) { return x * __builtin_amdgcn_rcpf(1.0f + __expf(-x)); }
DI float rsq_(float x) { return __builtin_amdgcn_rsqf(x); }
DI float softplus_(float x) { const float y = __expf(x); return (y < 0.03f) ? y * (1.0f - y * (0.5f - y * (0.33333333f - 0.25f * y))) : __logf(1.0f + y); }

struct Args { const float* in[22]; float* out; unsigned char* ws; int ph_lo, ph_hi; };
struct KIn {
    DI const float* operator[](int k) const { auto kp = __builtin_amdgcn_kernarg_segment_ptr(); asm volatile("" : "+s"(kp));
        return ((const float* const __attribute__((address_space(4)))*)kp)[k]; }
};
struct Frame { LAS unsigned char* lds; int tid, lane, wave, G, bid; KIn in; float* out; unsigned char* ws; };

struct TrDesc { const float* W; const float* scale; bf16* WT; int ldsrc, k0, c0, ldk, n0, koff; };
DI void tr_load(const TrDesc& d, float (&wv_)[32], float (&sc_)[8], int lane) {
#pragma unroll
    for (int i = 0; i < 32; ++i) { const int kk = 2 * i + (lane >> 5); wv_[i] = d.W[(size_t)(d.k0 + kk) * d.ldsrc + d.c0 + (lane & 31)]; }
    if (d.scale) { const f32x4 s0 = *(const f32x4*)(d.scale + d.k0 + 8 * (lane & 7)), s1 = *(const f32x4*)(d.scale + d.k0 + 8 * (lane & 7) + 4);
        sc_[0] = s0.x; sc_[1] = s0.y; sc_[2] = s0.z; sc_[3] = s0.w; sc_[4] = s1.x; sc_[5] = s1.y; sc_[6] = s1.z; sc_[7] = s1.w; }
    else {
#pragma unroll
        for (int j = 0; j < 8; ++j) sc_[j] = 1.0f; }
}
DI void tr_store(const TrDesc& d, const float (&wv_)[32], const float (&sc_)[8], LAS float* scr, int lane, bool nts) {
#pragma unroll
    for (int i = 0; i < 32; ++i) { const int kk = 2 * i + (lane >> 5); scr[kk * 33 + (lane & 31)] = wv_[i]; }
    LDS_WAIT(); asm volatile("" ::: "memory");
    const int c = lane & 7;
#pragma unroll
    for (int j = 0; j < 4; ++j) { const int n = (lane >> 3) + 8 * j; const LAS float* s = scr + (8 * c) * 33 + n;
        v4u o; o.x = pk2(s[0 * 33] * sc_[0], s[1 * 33] * sc_[1]); o.y = pk2(s[2 * 33] * sc_[2], s[3 * 33] * sc_[3]); o.z = pk2(s[4 * 33] * sc_[4], s[5 * 33] * sc_[5]); o.w = pk2(s[6 * 33] * sc_[6], s[7 * 33] * sc_[7]);
        v4u* wp_ = (v4u*)(d.WT + (size_t)(d.n0 + n) * d.ldk + d.koff + d.k0 + 8 * c); if (nts) __builtin_nontemporal_store(o, wp_); else *wp_ = o; }
    LDS_WAIT(); asm volatile("" ::: "memory");
}
constexpr int I_IN = 16 * 256, I_P = 16 * 32, I_FI = 16 * 176, I_FO = 44 * 32, I_L = I_IN + 3 * I_P + I_FI + I_FO, WT_CM = 1920, WT_DEFER = 2560;
DI TrDesc tr_decode(Frame& F, int it) {
    const int l = it / I_L; int r = it % I_L; unsigned char* wl = F.ws + WS_W + (size_t)l * W_LAYER; TrDesc d;
    if (r < I_IN) { const int kb = r / 256, nb = r % 256, n0 = 32 * nb, c0 = n0 + (n0 >= 4096 ? 16 : 0);
        d = TrDesc{F.in[5] + (size_t)l * DM * DIN, F.in[4] + l * DM, (bf16*)(wl + W_IN), DIN, 64 * kb, c0, DM, n0, 0}; return d; } r -= I_IN;
    if (r < I_P) { const int kb = r / 32, nb = r % 32; d = TrDesc{F.in[14] + (size_t)l * DM * DM, nullptr, (bf16*)(wl + W_PAB), DM, 64 * kb, 32 * nb, LD_PAB, 32 * nb, 0}; return d; } r -= I_P;
    if (r < I_P) { const int kb = r / 32, nb = r % 32; d = TrDesc{F.in[15] + (size_t)l * DM * DM, nullptr, (bf16*)(wl + W_PAB), DM, 64 * kb, 32 * nb, LD_PAB, 32 * nb, 1024}; return d; } r -= I_P;
    if (r < I_P) { const int kb = r / 32, nb = r % 32; d = TrDesc{F.in[16] + (size_t)l * DM * DM, nullptr, (bf16*)(wl + W_OUT), DM, 64 * kb, 32 * nb, DM, 32 * nb, 0}; return d; } r -= I_P;
    if (r < I_FI) { const int kb = r / 176, nb = r % 176, n0 = 32 * nb, p = n0 / 256, j = n0 % 256, c0 = (j < 128) ? 128 * p + j : DFF + 128 * p + (j - 128);
        d = TrDesc{F.in[19] + (size_t)l * DM * 2 * DFF, F.in[18] + l * DM, (bf16*)(wl + W_FIN), 2 * DFF, 64 * kb, c0, DM, n0, 0}; return d; } r -= I_FI;
    { const int kb = r / 32, nb = r % 32; d = TrDesc{F.in[20] + (size_t)l * DFF * DM, nullptr, (bf16*)(wl + W_FOUT), DM, 64 * kb, 32 * nb, DFF, 32 * nb, 0}; return d; }
}
DI void tr_range(Frame& F, int first, int last, int idx, int cnt) {
    LAS float* scr = (LAS float*)(F.lds + F.wave * 16384);
    const int it0 = first + idx;
    if (it0 < last) {
        float wa[32], sa[8], wb[32], sb[8];
        TrDesc d0 = tr_decode(F, it0); tr_load(d0, wa, sa, F.lane);
#pragma unroll 1
        for (int it = it0; it < last; it += cnt) {
            const bool hn = it + cnt < last;
            TrDesc d1 = d0; if (hn) { d1 = tr_decode(F, it + cnt); tr_load(d1, wb, sb, F.lane); }
            tr_store(d0, wa, sa, scr, F.lane, it >= I_L);
            d0 = d1;
#pragma unroll
            for (int i = 0; i < 32; ++i) wa[i] = wb[i];
#pragma unroll
            for (int i = 0; i < 8; ++i) sa[i] = sb[i];
        }
    }
}
DI void p0_weights(Frame& F) {
    tr_range(F, 0, I_L, F.bid * NWAVES + F.wave, F.G * NWAVES);
    for (int i = F.bid * 512 + F.tid; i < DEPTH * NH * 128 * 128; i += F.G * 512) { const int l = i >> 17, rem = i & 131071, ii = (rem >> 7) & 127, jj = rem & 127;
        ((bf16*)(F.ws + WS_W + (size_t)l * W_LAYER + W_SP))[rem] = (bf16)((jj <= ii) ? f2bf(F.in[12][i]) : 0u); }
}

constexpr int WAB_LDB = 2064, WAB_LO = 16 * WAB_LDB;
DI void wab_issue(Frame& F, int lab, float (&a_)[32], float (&b_)[32]) {
    const float* wp = F.in[5] + (size_t)lab * DM * DIN + 4096; const float* nw = F.in[4] + lab * DM;
#pragma unroll
    for (int j = 0; j < 32; ++j) { const int i = F.tid + j * (NWAVES * 64), c = i & 15, k = i >> 4; a_[j] = wp[(size_t)k * DIN + c]; b_[j] = nw[k]; }
}
DI void wab_commit(Frame& F, const float (&a_)[32], const float (&b_)[32]) {
    __syncthreads();
#pragma unroll
    for (int j = 0; j < 32; ++j) { const int i = F.tid + j * (NWAVES * 64), c = i & 15, k = i >> 4; const float w = a_[j] * b_[j]; const unsigned hi = f2bf(w); const float lo = w - bflo(hi);
        *(LAS unsigned short*)(F.lds + c * WAB_LDB + 2 * k) = (unsigned short)hi; *(LAS unsigned short*)(F.lds + WAB_LO + c * WAB_LDB + 2 * k) = (unsigned short)f2bf(lo); }
    __syncthreads();
}
DI void load_wab_lds(Frame& F, int lab) {
    float a_[32], b_[32]; wab_issue(F, lab, a_, b_); wab_commit(F, a_, b_);
}
DI void ab_tile(Frame& F, int lab, int t) {
    const int lane = F.lane, r = lane & 15, kg = lane >> 4;
    asm volatile("s_waitcnt vmcnt(0)" ::: "memory");
    const bf16* xp = (const bf16*)(F.ws + WS_XB) + (size_t)(16 * t + r) * DM + 8 * kg;
    const LAS unsigned char* bp = F.lds + r * WAB_LDB + 16 * kg;
    f32x4 acc = (f32x4){0.f, 0.f, 0.f, 0.f};
#pragma unroll 1
    for (int k0 = 0; k0 < 32; k0 += 8) {
        v4u xa[8];
#pragma unroll
        for (int kk = 0; kk < 8; ++kk) xa[kk] = *(const v4u*)(xp + 32 * (k0 + kk));
#pragma unroll
        for (int kk = 0; kk < 8; ++kk) { const pg8::bf16x8 av = __builtin_bit_cast(pg8::bf16x8, xa[kk]);
            const pg8::bf16x8 bh = *(const LAS pg8::bf16x8*)(bp + 64 * (k0 + kk)), bl = *(const LAS pg8::bf16x8*)(bp + WAB_LO + 64 * (k0 + kk));
            acc = __builtin_amdgcn_mfma_f32_16x16x32_bf16(av, bh, acc, 0, 0, 0); acc = __builtin_amdgcn_mfma_f32_16x16x32_bf16(av, bl, acc, 0, 0, 0); }
    }
    const float dtb = F.in[8][lab * NH + (r & 7)], alg = F.in[7][lab * NH + (r & 7)];
#pragma unroll
    for (int reg = 0; reg < 4; ++reg) { const float a = acc[reg]; float rr_;
        if (r < 8) { const float xx = a + dtb; const float sp = (xx > 20.f) ? xx : softplus_(xx); rr_ = -__expf(alg) * sp; } else rr_ = sigmoidf_(a);
        ((float*)(F.ws + WS_AB))[(size_t)(16 * t + 4 * kg + reg) * 16 + r] = rr_; }
}
constexpr int RB = 4;
DI void rowprep(Frame& F, const f32x4 (&v)[RB][4], const int (&row)[RB], const bool (&ok)[RB], int lab) {
    float s[RB];
#pragma unroll
    for (int k = 0; k < RB; ++k) { s[k] = 0.f;
#pragma unroll
        for (int j = 0; j < 4; ++j) s[k] += (v[k][j].x * v[k][j].x + v[k][j].y * v[k][j].y) + (v[k][j].z * v[k][j].z + v[k][j].w * v[k][j].w); }
    wave_sum_n<RB>(s);
    float rstd[RB];
#pragma unroll
    for (int k = 0; k < RB; ++k) { rstd[k] = rsq_(s[k] * (1.0f / DM) + 1e-6f);
        if (ok[k]) {
            v2u* xb = (v2u*)((bf16*)(F.ws + WS_XB) + (size_t)row[k] * DM) + F.lane;
#pragma unroll
            for (int j = 0; j < 4; ++j) { const f32x4 t = v[k][j] * rstd[k]; v2u o; o.x = pk2(t.x, t.y); o.y = pk2(t.z, t.w); xb[64 * j] = o; } } }
    (void)lab;
}
DI void p0_batch(Frame& F, const int (&row)[RB], const bool (&ok)[RB]) {
    f32x4 v[RB][4];
#pragma unroll
    for (int k = 0; k < RB; ++k) { const float* xr = (row[k] < TP) ? F.in[0] + (size_t)row[k] * DM : F.in[1] + (size_t)(row[k] - TP) * DM;
#pragma unroll
        for (int j = 0; j < 4; ++j) v[k][j] = __builtin_nontemporal_load(((const f32x4*)xr) + F.lane + 64 * j); }
    rowprep(F, v, row, ok, 0);
}
DI void p0_rows(Frame& F) {
    const int slot = F.wave * F.G + F.bid, NGW = F.G * NWAVES;
    for (int t = slot; t < TT / 16; t += NGW) {
#pragma unroll 1
        for (int it = 0; it < 4; ++it) { int row[RB]; bool ok[RB];
#pragma unroll
            for (int k = 0; k < RB; ++k) { row[k] = 16 * t + 4 * it + k; ok[k] = true; }
            p0_batch(F, row, ok); }
        ab_tile(F, 0, t);
    }
}
DI f32x4 unpk4_(v2u w) { return (f32x4){bflo(w.x), bfhi(w.x), bflo(w.y), bfhi(w.y)}; }
DI void rows_batch(Frame& F, const bf16* Y, const f32x4 (&ww)[4], const bf16* Y0, const f32x4 (&w0)[4], bool x_from_in, bool fin, bool wr, int lab, const int (&row)[RB], const bool (&ok)[RB]) {
    f32x4 x[RB][4]; float s[RB];
    {
        v2u yw[RB][4], y0w[RB][4];
#pragma unroll
        for (int k = 0; k < RB; ++k) {
            const float* xr = x_from_in ? ((row[k] < TP) ? F.in[0] + (size_t)row[k] * DM : F.in[1] + (size_t)(row[k] - TP) * DM) : F.out + (size_t)row[k] * DM;
#pragma unroll
            for (int j = 0; j < 4; ++j) { yw[k][j] = __builtin_nontemporal_load(((const v2u*)(Y + (size_t)row[k] * DM)) + F.lane + 64 * j); if (Y0) y0w[k][j] = __builtin_nontemporal_load(((const v2u*)(Y0 + (size_t)row[k] * DM)) + F.lane + 64 * j);
                x[k][j] = __builtin_nontemporal_load(((const f32x4*)xr) + F.lane + 64 * j); } }
        if (Y0) {
#pragma unroll
            for (int k = 0; k < RB; ++k) { s[k] = 0.f;
#pragma unroll
                for (int j = 0; j < 4; ++j) { const f32x4 y = unpk4_(y0w[k][j]); s[k] += (y.x * y.x + y.y * y.y) + (y.z * y.z + y.w * y.w); } }
            wave_sum_n<RB>(s);
#pragma unroll
            for (int k = 0; k < RB; ++k) { const float ry = rsq_(s[k] * (1.0f / DM) + 1e-6f);
#pragma unroll
                for (int j = 0; j < 4; ++j) x[k][j] = x[k][j] + unpk4_(y0w[k][j]) * ry * w0[j]; }
        }
#pragma unroll
        for (int k = 0; k < RB; ++k) { s[k] = 0.f;
#pragma unroll
            for (int j = 0; j < 4; ++j) { const f32x4 y = unpk4_(yw[k][j]); s[k] += (y.x * y.x + y.y * y.y) + (y.z * y.z + y.w * y.w); } }
        wave_sum_n<RB>(s);
#pragma unroll
        for (int k = 0; k < RB; ++k) { const float ry = rsq_(s[k] * (1.0f / DM) + 1e-6f);
#pragma unroll
            for (int j = 0; j < 4; ++j) { x[k][j] = x[k][j] + unpk4_(yw[k][j]) * ry * ww[j]; if (wr && ok[k]) __builtin_nontemporal_store(x[k][j], ((f32x4*)(F.out + (size_t)row[k] * DM)) + F.lane + 64 * j); } }
    }
    if (!fin) rowprep(F, x, row, ok, lab);
}
DI void rows_residual(Frame& F, const bf16* Y, const float* w, const bf16* Y0, const float* w0p, bool x_from_in, bool fin, bool wr, int lab) {
    const bool tilemaj = !fin && lab >= 0;
    if (tilemaj) load_wab_lds(F, lab);
    const int gw = F.bid * NWAVES + F.wave, NGW = F.G * NWAVES;
    f32x4 ww[4], w0[4];
#pragma unroll
    for (int j = 0; j < 4; ++j) { ww[j] = ((const f32x4*)w)[F.lane + 64 * j]; w0[j] = ((const f32x4*)w0p)[F.lane + 64 * j]; }
    if (tilemaj) {
        const int slot = F.wave * F.G + F.bid;
        for (int t = slot; t < TT / 16; t += NGW) {
#pragma unroll 1
            for (int it = 0; it < 4; ++it) { int row[RB]; bool ok[RB];
#pragma unroll
                for (int k = 0; k < RB; ++k) { row[k] = 16 * t + 4 * it + k; ok[k] = true; }
                rows_batch(F, Y, ww, Y0, w0, x_from_in, fin, wr, lab, row, ok); }
            ab_tile(F, lab, t);
        }
    } else {
        for (int base = gw; base < TT; base += NGW * RB) { int row[RB]; bool ok[RB];
#pragma unroll
            for (int k = 0; k < RB; ++k) { const int r = base + k * NGW; ok[k] = r < TT; row[k] = ok[k] ? r : base; }
            rows_batch(F, Y, ww, Y0, w0, x_from_in, fin, wr, lab, row, ok); }
    }
}

typedef short s16x4 __attribute__((ext_vector_type(4)));
typedef short bf16x8 __attribute__((ext_vector_type(8)));
typedef float f32x8 __attribute__((ext_vector_type(8)));
typedef float f32x16 __attribute__((ext_vector_type(16)));
typedef float f32x2_ __attribute__((ext_vector_type(2)));
typedef __bf16 bfv8 __attribute__((ext_vector_type(8)));
#define MFMA32(a, b, c) __builtin_amdgcn_mfma_f32_32x32x16_bf16((a), (b), (c), 0, 0, 0)
DI int crow(int reg, int h) { return (reg & 3) + 8 * (reg >> 2) + 4 * h; }
DI bf16x8 pack_lo(const f32x16& x) { const f32x8 v = __builtin_shufflevector(x, x, 0, 1, 2, 3, 4, 5, 6, 7); return __builtin_bit_cast(bf16x8, __builtin_convertvector(v, bfv8)); }
DI bf16x8 pack_hi(const f32x16& x) { const f32x8 v = __builtin_shufflevector(x, x, 8, 9, 10, 11, 12, 13, 14, 15); return __builtin_bit_cast(bf16x8, __builtin_convertvector(v, bfv8)); }
DI f32x16 zero16() { f32x16 z;
#pragma unroll
    for (int i = 0; i < 16; ++i) z[i] = 0.f; return z; }

DI void e1_conv_sample(Frame& F, int l) {
    const int gw = F.bid * NWAVES + F.wave, NGW = F.G * NWAVES, lane = F.lane;
    const bf16* raw = (const bf16*)(F.ws + WS_QKVRAW); bf16* qc = (bf16*)(F.ws + WS_QKVS);
    const float* cw = F.in[6] + (size_t)l * 4 * DCONV; const float* scin = F.in[3];
    for (int it = gw; it < TSM * 3; it += NGW) {
        const int srow = it / 3, part = it - 3 * srow, row = TP + srow, seq = srow / TS_, t = srow % TS_;
        const float* sc = scin + ((size_t)l * NS + seq) * 3 * DCONV;
        float* sco = F.out + O_SCS + ((size_t)l * NS + seq) * 3 * DCONV;
        { constexpr int s0 = 0;
            unsigned xw[4][8]; f32x2_ sv[4][8], wv[4][8];
#pragma unroll
            for (int i = 0; i < 4; ++i) { const int tt = t - 3 + i, si = (t + i) < 3 ? (t + i) : 2;
#pragma unroll
                for (int sg = 0; sg < 8; ++sg) { const int ch = part * 1024 + (s0 + sg) * 128 + 2 * lane;
                    xw[i][sg] = *(const unsigned*)(raw + (size_t)(tt >= 0 ? row - 3 + i : row) * DCONV + ch);
                    sv[i][sg] = *(const f32x2_*)(sc + (size_t)si * DCONV + ch); wv[i][sg] = *(const f32x2_*)(cw + i * DCONV + ch); } }
            float a0[8], a1[8], ss[8];
#pragma unroll
            for (int sg = 0; sg < 8; ++sg) { a0[sg] = 0.f; a1[sg] = 0.f;
#pragma unroll
                for (int i = 0; i < 4; ++i) { const int tt = t - 3 + i; const float x0 = tt >= 0 ? bflo(xw[i][sg]) : sv[i][sg].x, x1 = tt >= 0 ? bfhi(xw[i][sg]) : sv[i][sg].y; a0[sg] += wv[i][sg].x * x0; a1[sg] += wv[i][sg].y * x1; }
                if (t >= TS_ - 3) { const int ch = part * 1024 + (s0 + sg) * 128 + 2 * lane; *(f32x2_*)(sco + (size_t)(t - (TS_ - 3)) * DCONV + ch) = (f32x2_){bflo(xw[3][sg]), bfhi(xw[3][sg])}; }
                a0[sg] = siluf_(a0[sg]); a1[sg] = siluf_(a1[sg]); ss[sg] = a0[sg] * a0[sg] + a1[sg] * a1[sg]; }
            if (part < 2) wave_sum_n<8>(ss);
#pragma unroll
            for (int sg = 0; sg < 8; ++sg) { const float scl = (part < 2) ? rsq_(ss[sg] + 1e-6f) * (part == 0 ? 0.08838834764831845f : 1.0f) : 1.0f;
                *(unsigned*)(qc + (size_t)srow * DCONV + part * 1024 + (s0 + sg) * 128 + 2 * lane) = pk2(a0[sg] * scl, a1[sg] * scl); }
        }
    }
}

constexpr int PL_KN = 0, PL_QS = 17408, PL_RT = 34816, PL_AF = 71680, PL_AB = 89088, PL_T = 91648, PL_T0T = 100864, PL_G = 103424, PL_RT2 = 103936, PL_RTB = PL_RT2 - PL_RT;
constexpr int KN_LD = 136, RT_LD = 72, AF_LD = 68, AB_LD = 40, T_LD = 72, T0T_LD = 40;
DI bf16x8 lds_frag(const LAS unsigned char* p) { return *(const LAS bf16x8*)p; }
DI bf16x8 lds_frag_perm(const LAS unsigned char* p) {
    const s16x4 lo = *(const LAS s16x4*)p, hi = *(const LAS s16x4*)(p + 16); return __builtin_shufflevector(lo, hi, 0, 1, 2, 3, 4, 5, 6, 7); }
struct PrepIn { unsigned xr[3][11]; unsigned xv0[11]; float gl, bl; };
DI void prep_load(Frame& F, int unit, PrepIn& pi) {
    const int c = unit & 31, h = (unit >> 5) & 7, b = unit >> 8, row0 = b * SEQ + 64 * c, i0 = 8 * F.wave, cp = F.lane;
    const bf16* raw = (const bf16*)(F.ws + WS_QKVRAW); const float* ab = (const float*)(F.ws + WS_AB);
    pi.gl = ab[(size_t)(row0 + F.lane) * 16 + h]; pi.bl = ab[(size_t)(row0 + F.lane) * 16 + 8 + h];
#pragma unroll
    for (int a = 0; a < 3; ++a) { const int col = a * 1024 + h * HD + 2 * cp;
#pragma unroll
        for (int ii = 0; ii < 11; ++ii) { const int tt = 64 * c + i0 - 3 + ii; pi.xr[a][ii] = *(const unsigned*)(raw + (size_t)(tt >= 0 ? row0 + i0 - 3 + ii : row0) * DCONV + col); } }
    if (F.wave == 5) { const int col = 2 * 1024 + h * HD + 2 * cp;
#pragma unroll
        for (int ii = 0; ii < 11; ++ii) { const int tt = 64 * c - 3 + ii; pi.xv0[ii] = *(const unsigned*)(raw + (size_t)(tt >= 0 ? row0 - 3 + ii : row0) * DCONV + col); } }
}
DI void prep_s1(Frame& F, int l, int unit, PrepIn& pi, int next_unit, int rtoff) {
    const int c = unit & 31, h = (unit >> 5) & 7, b = unit >> 8;
    const int row0 = b * SEQ + 64 * c, w = F.wave, lane = F.lane, r = lane & 31, hh = lane >> 5;
    LAS unsigned char* lds = F.lds;
    unsigned char* rec = F.ws + WS_REC + (size_t)unit * REC_BYTES;
    (void)c; (void)h; (void)b; (void)row0; (void)r; (void)hh; (void)rec; (void)w; (void)lds;
    const float* cw = F.in[6] + (size_t)l * 4 * DCONV;
    const float gl = pi.gl, bl = pi.bl;
    float gc = gl;
    gc = wave_scan_incl(gc);
    const float glast = lane_bcast(gc, 63);
    const float eg_ = __expf(gc), dg_ = __expf(glast - gc), be_ = bl * eg_;
    if (w == 0) { ((LAS float*)(lds + PL_G))[lane] = gc; ((LAS float*)(lds + PL_G))[64 + lane] = bl; if (lane == 0) ((float*)(F.ws + WS_EG))[unit] = __expf(glast); }
    {
        const int cp = lane;
#pragma unroll
        for (int ps = 0; ps < 4; ++ps) {
            const int a = (ps < 3) ? ps : 2;
            if (!((ps < 2) || (ps == 2 && w != 0) || (ps == 3 && w == 5))) continue;
            const int i0 = (ps == 3) ? 0 : 8 * w;
            const unsigned (&xs)[11] = (ps == 3) ? pi.xv0 : pi.xr[a];
            const int col = a * 1024 + h * HD + 2 * cp; f32x2_ x[11];
#pragma unroll
            for (int ii = 0; ii < 11; ++ii) { x[ii].x = bflo(xs[ii]); x[ii].y = bfhi(xs[ii]); }
            if (c == 0 && i0 == 0) { x[0] = (f32x2_){0.f, 0.f}; x[1] = (f32x2_){0.f, 0.f}; x[2] = (f32x2_){0.f, 0.f}; }
            f32x2_ wv[4];
#pragma unroll
            for (int i = 0; i < 4; ++i) wv[i] = *(const f32x2_*)(cw + i * DCONV + col);
            if (c == 31 && w == 7) {
                float* sco = F.out + O_SCP + ((size_t)l * NB + b) * 3 * DCONV + col;
#pragma unroll
                for (int j = 0; j < 3; ++j) { sco[(size_t)j * DCONV] = x[8 + j].x; sco[(size_t)j * DCONV + 1] = x[8 + j].y; }
            }
            float y[8][2];
#pragma unroll
            for (int rr = 0; rr < 8; ++rr) { f32x2_ acc = wv[0] * x[rr];
#pragma unroll
                for (int i = 1; i < 4; ++i) acc = wv[i] * x[rr + i] + acc;
                y[rr][0] = siluf_(acc.x); y[rr][1] = siluf_(acc.y); }
            if (a < 2) {
                float ssq[8];
#pragma unroll
                for (int rr = 0; rr < 8; ++rr) ssq[rr] = y[rr][0] * y[rr][0] + y[rr][1] * y[rr][1];
                const float scv = rsq_(wave_sum8t(ssq, lane) + 1e-6f) * (a == 0 ? 0.08838834764831845f : 1.0f);
#pragma unroll
                for (int rr = 0; rr < 8; ++rr) { const float sc = lane_bcast(scv, (rr >> 2) + 2 * ((rr >> 1) & 1) + 4 * (rr & 1)); const f32x2_ t2 = (f32x2_){y[rr][0], y[rr][1]} * sc; y[rr][0] = t2.x; y[rr][1] = t2.y; }
            }
            if (a == 0) {
#pragma unroll
                for (int rr = 0; rr < 8; ++rr) { const int i = i0 + rr; const float ei = lane_bcast(eg_, i0 + rr);
                    *(LAS unsigned*)(lds + PL_QS + (i * KN_LD + 2 * cp) * 2) = pk2(y[rr][0], y[rr][1]);
                    const int dk = 2 * cp, fidx = (((i >> 5) * 4 + (dk >> 5)) * 2 + ((dk >> 4) & 1)), ln = (i & 31) + 32 * ((dk >> 2) & 1), el = ((dk >> 3) & 1) * 4 + (dk & 3);
                    *(unsigned*)(rec + R_QG + fidx * 1024 + ln * 16 + el * 2) = pk2(y[rr][0] * ei, y[rr][1] * ei); }
            } else {
                unsigned r0[4], r1[4];
#pragma unroll
                for (int q = 0; q < 4; ++q) { const float fa_ = (a == 1) ? lane_bcast(be_, i0 + 2 * q) : lane_bcast(bl, i0 + 2 * q), fb_ = (a == 1) ? lane_bcast(be_, i0 + 2 * q + 1) : lane_bcast(bl, i0 + 2 * q + 1);
                    r0[q] = pk2(y[2 * q][0] * fa_, y[2 * q + 1][0] * fb_); r1[q] = pk2(y[2 * q][1] * fa_, y[2 * q + 1][1] * fb_); }
                const int n0 = (a == 1 ? 128 : 0) + 2 * cp;
                *(LAS v4u*)(lds + PL_RT + rtoff + (n0 * RT_LD + i0) * 2) = (v4u){r0[0], r0[1], r0[2], r0[3]};
                *(LAS v4u*)(lds + PL_RT + rtoff + ((n0 + 1) * RT_LD + i0) * 2) = (v4u){r1[0], r1[1], r1[2], r1[3]};
                if (a == 1) {
#pragma unroll
                    for (int rr = 0; rr < 8; ++rr) *(LAS unsigned*)(lds + PL_KN + ((i0 + rr) * KN_LD + 2 * cp) * 2) = pk2(y[rr][0], y[rr][1]);
                    float d[8];
#pragma unroll
                    for (int rr = 0; rr < 8; ++rr) d[rr] = lane_bcast(dg_, i0 + rr);
#pragma unroll
                    for (int e = 0; e < 2; ++e) { const int dk = 2 * cp + e; const int fidx = ((dk >> 5) * 2 + (i0 >> 5)) * 2 + ((i0 >> 4) & 1), el = ((i0 >> 3) & 1) * 4;
                        *(v2u*)(rec + R_KGT + fidx * 1024 + ((dk & 31)) * 16 + el * 2) = (v2u){pk2(y[0][e] * d[0], y[1][e] * d[1]), pk2(y[2][e] * d[2], y[3][e] * d[3])};
                        *(v2u*)(rec + R_KGT + fidx * 1024 + ((dk & 31) + 32) * 16 + el * 2) = (v2u){pk2(y[4][e] * d[4], y[5][e] * d[5]), pk2(y[6][e] * d[6], y[7][e] * d[7])}; }
                }
            }
        }
    }
    if (next_unit >= 0) prep_load(F, next_unit, pi);
}
DI void prep_s2(Frame& F, int unit) {
    const int c = unit & 31, h = (unit >> 5) & 7, b = unit >> 8;
    const int row0 = b * SEQ + 64 * c, w = F.wave, lane = F.lane, r = lane & 31, hh = lane >> 5;
    LAS unsigned char* lds = F.lds;
    unsigned char* rec = F.ws + WS_REC + (size_t)unit * REC_BYTES;
    (void)c; (void)h; (void)b; (void)row0; (void)r; (void)hh; (void)rec; (void)w; (void)lds;
    if (w < 6) {
        int ln_ = lane; asm volatile("" : "+v"(ln_)); const int r = ln_ & 31, hh = ln_ >> 5;
        const int ta = (w == 1 || w == 2 || w == 5) ? 1 : 0, tb = (w == 2 || w == 4 || w == 5) ? 1 : 0; const bool iskk = w < 3;
        f32x16 acc = zero16();
        const LAS unsigned char* ap = lds + PL_KN + ((32 * ta + r) * KN_LD + 8 * hh) * 2;
        const LAS unsigned char* bp = lds + (iskk ? PL_KN : PL_QS) + ((32 * tb + r) * KN_LD + 8 * hh) * 2;
#pragma unroll
        for (int ks = 0; ks < 8; ++ks) acc = MFMA32(lds_frag(ap + ks * 32), lds_frag(bp + ks * 32), acc);
        const LAS float* gcl = (const LAS float*)(lds + PL_G); const LAS float* bel = gcl + 64;
        const int cidx = 32 * tb + r; const float gcc = gcl[cidx];
        if (iskk) {
#pragma unroll
            for (int reg = 0; reg < 16; ++reg) { const int i = 32 * ta + crow(reg, hh); const float v = (i > cidx) ? bel[i] * acc[reg] * __expf(gcl[i] - gcc) : 0.f;
                *(LAS float*)(lds + PL_AF + (i * AF_LD + cidx) * 4) = v;
                if (w == 1) *(LAS unsigned short*)(lds + PL_AB + ((i - 32) * AB_LD + cidx) * 2) = (unsigned short)f2bf(v); }
        } else {
#pragma unroll
            for (int reg = 0; reg < 16; ++reg) { const int j = 32 * ta + crow(reg, hh); acc[reg] = (cidx >= j) ? acc[reg] * __expf(gcc - gcl[j]) : 0.f; }
            unsigned char* dst = rec + R_QK + (size_t)((tb * 2 + ta) * 2) * 1024 + ln_ * 16;
            *(bf16x8*)dst = pack_lo(acc); *(bf16x8*)(dst + 1024) = pack_hi(acc);
        }
    }
}
constexpr int PL_PI = 140800, PI_LD = 40;
DI bf16x8 cvt8_(f32x4 a, f32x4 b) { const f32x8 v = __builtin_shufflevector(a, b, 0, 1, 2, 3, 4, 5, 6, 7); return __builtin_bit_cast(bf16x8, __builtin_convertvector(v, bfv8)); }
DI void prep_s34(Frame& F) {
    const int w = 0; LAS unsigned char* lds = F.lds;
    if (w == 0) {
        int ln_ = F.lane; asm volatile("" : "+v"(ln_)); const int r = ln_ & 31, hh = ln_ >> 5;
        f32x16 P[2], R[2]; bf16x8 L0[2], L1[2];
#pragma unroll
        for (int b = 0; b < 2; ++b) { const LAS float* ab = (const LAS float*)(lds + PL_AF) + (32 * b) * AF_LD + 32 * b;
#pragma unroll
            for (int reg = 0; reg < 16; ++reg) { const float v = ab[crow(reg, hh) * AF_LD + r]; P[b][reg] = v; R[b][reg] = ((crow(reg, hh) == r) ? 1.f : 0.f) - v; }
            const LAS float* ar = ab + r * AF_LD + 4 * hh;
            const f32x4 a0 = *(const LAS f32x4*)ar, a1 = *(const LAS f32x4*)(ar + 8), a2 = *(const LAS f32x4*)(ar + 16), a3 = *(const LAS f32x4*)(ar + 24);
            L0[b] = cvt8_(a0, a1); L1[b] = cvt8_(a2, a3); }
#pragma unroll
        for (int j = 1; j <= 4; ++j) {
#pragma unroll
            for (int b = 0; b < 2; ++b) { const bf16x8 pl = pack_lo(P[b]), ph = pack_hi(P[b]);
                f32x16 z = zero16(); z = MFMA32(L0[b], pl, z); z = MFMA32(L1[b], ph, z); P[b] = z; }
#pragma unroll
            for (int b = 0; b < 2; ++b) { LAS unsigned char* img = lds + PL_PI + b * (32 * PI_LD * 2) + r * 2;
#pragma unroll
                for (int reg = 0; reg < 16; reg += 2) { const unsigned pw = pg8::cvt_pk_bf16(P[b][reg], P[b][reg + 1]);
                    *(LAS unsigned short*)(img + crow(reg, hh) * (PI_LD * 2)) = (unsigned short)pw; *(LAS unsigned short*)(img + crow(reg + 1, hh) * (PI_LD * 2)) = (unsigned short)(pw >> 16); } }
            asm volatile("" ::: "memory");
#pragma unroll
            for (int b = 0; b < 2; ++b) { const LAS unsigned char* ip = lds + PL_PI + b * (32 * PI_LD * 2) + (r * PI_LD + 4 * hh) * 2;
                L0[b] = lds_frag_perm(ip); L1[b] = lds_frag_perm(ip + 32);
                const bf16x8 rl = pack_lo(R[b]), rh = pack_hi(R[b]);
                R[b] = MFMA32(L0[b], rl, R[b]); R[b] = MFMA32(L1[b], rh, R[b]); }
            asm volatile("" ::: "memory");
        }
#pragma unroll
        for (int b = 0; b < 2; ++b) { LAS unsigned char* tp = lds + PL_T + ((32 * b) * T_LD + 32 * b + r) * 2;
#pragma unroll
            for (int reg = 0; reg < 16; reg += 2) { const unsigned pw = pg8::cvt_pk_bf16(R[b][reg], R[b][reg + 1]);
                *(LAS unsigned short*)(tp + crow(reg, hh) * (T_LD * 2)) = (unsigned short)pw; *(LAS unsigned short*)(tp + crow(reg + 1, hh) * (T_LD * 2)) = (unsigned short)(pw >> 16); } }
        { LAS v4u* zp = (LAS v4u*)(lds + PL_T + ((ln_ >> 1) * T_LD + 32 + 16 * (ln_ & 1)) * 2); zp[0] = (v4u){0u, 0u, 0u, 0u}; zp[1] = (v4u){0u, 0u, 0u, 0u}; }
#pragma unroll
        for (int g = 0; g < 4; ++g) *(LAS v2u*)(lds + PL_T0T + (r * T0T_LD + 8 * g + 4 * hh) * 2) = (v2u){pg8::cvt_pk_bf16(R[0][4 * g], R[0][4 * g + 1]), pg8::cvt_pk_bf16(R[0][4 * g + 2], R[0][4 * g + 3])};
        asm volatile("" ::: "memory");
    }
    if (w == 0) {
        int ln_ = F.lane; asm volatile("" : "+v"(ln_)); const int r = ln_ & 31, hh = ln_ >> 5;
        f32x16 P = zero16();
#pragma unroll
        for (int s2 = 0; s2 < 2; ++s2) P = MFMA32(lds_frag(lds + PL_AB + (r * AB_LD + 16 * s2 + 8 * hh) * 2), lds_frag(lds + PL_T0T + (r * T0T_LD + 16 * s2 + 8 * hh) * 2), P);
        f32x16 X = zero16();
        X = MFMA32(lds_frag_perm(lds + PL_T + ((32 + r) * T_LD + 32 + 4 * hh) * 2), pack_lo(P), X);
        X = MFMA32(lds_frag_perm(lds + PL_T + ((32 + r) * T_LD + 32 + 16 + 4 * hh) * 2), pack_hi(P), X);
#pragma unroll
        for (int reg = 0; reg < 16; ++reg) *(LAS unsigned short*)(lds + PL_T + ((32 + crow(reg, hh)) * T_LD + r) * 2) = (unsigned short)f2bf(-X[reg]);
    }
}
DI void prep_s5(Frame& F, int unit, int rtoff) {
    const int c = unit & 31, h = (unit >> 5) & 7, b = unit >> 8;
    const int row0 = b * SEQ + 64 * c, w = F.wave, lane = F.lane, r = lane & 31, hh = lane >> 5;
    LAS unsigned char* lds = F.lds;
    unsigned char* rec = F.ws + WS_REC + (size_t)unit * REC_BYTES;
    (void)c; (void)h; (void)b; (void)row0; (void)r; (void)hh; (void)rec; (void)w; (void)lds;
    int ln5_ = lane; asm volatile("" : "+v"(ln5_));
    if (w < 4) {
        const int r = ln5_ & 31, hh = ln5_ >> 5;
#pragma unroll
        for (int mt = 0; mt < 2; ++mt) { f32x16 acc = zero16();
#pragma unroll
            for (int ks = 0; ks < 4; ++ks) if (ks < 2 * (mt + 1)) acc = MFMA32(lds_frag(lds + PL_T + ((32 * mt + r) * T_LD + 16 * ks + 8 * hh) * 2), lds_frag(lds + PL_RT + rtoff + ((32 * w + r) * RT_LD + 16 * ks + 8 * hh) * 2), acc);
            unsigned char* dst = rec + R_U + (size_t)((w * 2 + mt) * 64 + lane) * 32;
            *(bf16x8*)dst = pack_lo(acc); *(bf16x8*)(dst + 16) = pack_hi(acc); }
    } else {
        const int kt = w - 4, r = ln5_ & 31, hh = ln5_ >> 5;
#pragma unroll
        for (int it = 0; it < 2; ++it) { f32x16 acc = zero16();
#pragma unroll
            for (int ks = 0; ks < 4; ++ks) if (ks < 2 * (it + 1)) acc = MFMA32(lds_frag(lds + PL_RT + rtoff + ((128 + 32 * kt + r) * RT_LD + 16 * ks + 8 * hh) * 2), lds_frag(lds + PL_T + ((32 * it + r) * T_LD + 16 * ks + 8 * hh) * 2), acc);
#pragma unroll
            for (int reg = 0; reg < 16; ++reg) acc[reg] = -acc[reg];
            unsigned char* dst = rec + R_WN + (size_t)(((it * 4 + kt) * 2) * 64 + lane) * 16;
            *(bf16x8*)dst = pack_lo(acc); *(bf16x8*)(dst + 1024) = pack_hi(acc); }
    }
}
DI void prep_phase(Frame& F, int l) {
    constexpr int NU = NB * NH * 32;
    if (F.bid < NU) {
        PrepIn pi; const int u0 = F.bid;
        prep_load(F, u0, pi);
        prep_s1(F, l, u0, pi, (u0 + F.G < NU) ? u0 + F.G : -1, 0); __syncthreads();
        prep_s2(F, u0); __syncthreads();
#pragma unroll 1
        for (int k = 0; ; ++k) { const int u = u0 + k * F.G, un = u + F.G; const bool has_next = un < NU;
            if (F.wave == 0) prep_s34(F);
            if (has_next) prep_s1(F, l, un, pi, (un + F.G < NU) ? un + F.G : -1, ((k + 1) & 1) * PL_RTB);
            __syncthreads();
            prep_s5(F, u, (k & 1) * PL_RTB);
            if (has_next) prep_s2(F, un);
            __syncthreads();
            if (!has_next) break;
        }
    }
    e1_conv_sample(F, l);
}

constexpr int SC_OB = 2 * REC_FRAG_BYTES, OB_LD = 136, OB_BYTES = 64 * OB_LD * 2, SC_DNW = SC_OB + 2 * OB_BYTES;
DI void scan_finish(Frame& F, int l, int b, int h, int c, const LAS unsigned char* ob, const v4u (&zr)[4], int t4) {
    const int row = t4 >> 2, seg = t4 & 3;
    const LAS float* dnw = (const LAS float*)(F.lds + SC_DNW) + seg * 32;
    v4u ov[4]; float ss = 0.f;
#pragma unroll
    for (int q = 0; q < 4; ++q) { ov[q] = *(const LAS v4u*)(ob + row * (OB_LD * 2) + seg * 64 + q * 16);
#pragma unroll
        for (int e = 0; e < 4; ++e) { const float a = bflo(ov[q][e]), bb = bfhi(ov[q][e]); ss += a * a + bb * bb; } }
    ss += __shfl_xor(ss, 1); ss += __shfl_xor(ss, 2);
    const float rs = rsq_(ss * (1.0f / HD) + 1e-6f);
    bf16* dst = (bf16*)(F.ws + WS_OAB) + (size_t)(b * SEQ + 64 * c + row) * LD_OAB + h * HD + seg * 32;
#pragma unroll
    for (int q = 0; q < 4; ++q) { v4u o4;
#pragma unroll
        for (int e = 0; e < 4; ++e) { const float a = bflo(ov[q][e]) * rs * dnw[q * 8 + 2 * e] * siluf_(bflo(zr[q][e])), bb = bfhi(ov[q][e]) * rs * dnw[q * 8 + 2 * e + 1] * siluf_(bfhi(zr[q][e])); o4[e] = pk2(a, bb); }
        *(v4u*)(dst + q * 8) = o4; }
}
DI void scan_unit(Frame& F, int l, int bh) {
    const int w = F.wave, lane = F.lane, r = lane & 31, hh = lane >> 5, b = bh >> 3, h = bh & 7;
    LAS unsigned char* lds = F.lds;
    const unsigned char* rec0 = F.ws + WS_REC + (size_t)bh * 32 * REC_BYTES;
    const float egl = ((const float*)(F.ws + WS_EG))[bh * 32 + (lane & 31)];
    const int t4 = F.tid - 256;
    const bf16* zbase = (const bf16*)(F.ws + WS_Z) + (size_t)(b * SEQ + (t4 >> 2)) * DM + h * HD + (t4 & 3) * 32;
    f32x16 S[4];
#pragma unroll
    for (int k = 0; k < 4; ++k) S[k] = zero16();
#define SCAN_DMA(cidx, buf) do { const unsigned char* src_ = rec0 + (size_t)(cidx) * REC_BYTES; _Pragma("unroll") for (int it_ = 0; it_ < 7; ++it_) \
        if (!(it_ == 6 && (w == 2 || w == 3)))   \
        __builtin_amdgcn_global_load_lds((const unsigned*)(src_ + (it_ * 8 + w) * 1024 + lane * 16), (LAS unsigned*)(lds + (buf) * REC_FRAG_BYTES + (it_ * 8 + w) * 1024), 16, 0, 2); } while (0)
    SCAN_DMA(0, 0);
    v4u pf[4];
    if (F.tid < HD) ((LAS float*)(lds + SC_DNW))[F.tid] = F.in[9][l * HD + F.tid];
    if (w < 4) {
#pragma unroll
        for (int mt = 0; mt < 2; ++mt) { const unsigned char* up = rec0 + R_U + (size_t)((w * 2 + mt) * 64 + lane) * 32; pf[mt * 2] = *(const v4u*)up; pf[mt * 2 + 1] = *(const v4u*)(up + 16); }
    }
#pragma unroll 1
    for (int c = 0; c < 32; ++c) {
        if (w < 4 || c < 2) asm volatile("s_waitcnt vmcnt(0)" ::: "memory"); else asm volatile("s_waitcnt vmcnt(4)" ::: "memory");
        __syncthreads();
        if (w < 4) {
            f32x16 vn[2];
#pragma unroll
            for (int mt = 0; mt < 2; ++mt)
#pragma unroll
                for (int q = 0; q < 2; ++q)
#pragma unroll
                    for (int e = 0; e < 4; ++e) { vn[mt][q * 8 + 2 * e] = bflo(pf[mt * 2 + q][e]); vn[mt][q * 8 + 2 * e + 1] = bfhi(pf[mt * 2 + q][e]); }
            __builtin_amdgcn_sched_barrier(0);
            if (c + 1 < 32) {
                SCAN_DMA(c + 1, (c + 1) & 1);
#pragma unroll
                for (int mt = 0; mt < 2; ++mt) { const unsigned char* up = rec0 + (size_t)(c + 1) * REC_BYTES + R_U + (size_t)((w * 2 + mt) * 64 + lane) * 32; pf[mt * 2] = *(const v4u*)up; pf[mt * 2 + 1] = *(const v4u*)(up + 16); }
            }
            __builtin_amdgcn_sched_barrier(0);
            const LAS unsigned char* fb = lds + (c & 1) * REC_FRAG_BYTES + lane * 16;
            const float eg = __shfl(egl, c);
            f32x16 o[2]; o[0] = zero16(); o[1] = zero16();
            bf16x8 f0[4], f1[4], f2[4];
#define SB_ __builtin_amdgcn_sched_barrier(0)
#define LDW(kt, s2, f) do { f[0] = lds_frag(fb + R_WN + ((0 * 4 + (kt)) * 2 + (s2)) * 1024); f[1] = lds_frag(fb + R_WN + ((1 * 4 + (kt)) * 2 + (s2)) * 1024); \
                f[2] = lds_frag(fb + R_QG + ((0 * 4 + (kt)) * 2 + (s2)) * 1024); f[3] = lds_frag(fb + R_QG + ((1 * 4 + (kt)) * 2 + (s2)) * 1024); SB_; } while (0)
#define MMW(kt, s2, f) do { const bf16x8 sb_ = (s2) ? pack_hi(S[kt]) : pack_lo(S[kt]); \
                vn[0] = MFMA32(f[0], sb_, vn[0]); vn[1] = MFMA32(f[1], sb_, vn[1]); o[0] = MFMA32(f[2], sb_, o[0]); o[1] = MFMA32(f[3], sb_, o[1]); SB_; } while (0)
#define LDQK(s2, f) do { f[0] = lds_frag(fb + R_QK + ((0 * 2 + 0) * 2 + (s2)) * 1024); f[1] = lds_frag(fb + R_QK + ((1 * 2 + 0) * 2 + (s2)) * 1024); f[2] = lds_frag(fb + R_QK + ((1 * 2 + 1) * 2 + (s2)) * 1024); SB_; } while (0)
#define LDK(it, s2, f) do { _Pragma("unroll") for (int kt_ = 0; kt_ < 4; ++kt_) f[kt_] = lds_frag(fb + R_KGT + ((kt_ * 2 + (it)) * 2 + (s2)) * 1024); SB_; } while (0)
#define MMK(f, vb_) do { _Pragma("unroll") for (int kt_ = 0; kt_ < 4; ++kt_) S[kt_] = MFMA32(f[kt_], vb_, S[kt_]); SB_; } while (0)
            LDW(0, 0, f0); LDW(0, 1, f1);
            LDW(1, 0, f2); MMW(0, 0, f0);
            LDW(1, 1, f0); MMW(0, 1, f1);
            LDW(2, 0, f1); MMW(1, 0, f2);
            LDW(2, 1, f2); MMW(1, 1, f0);
            LDW(3, 0, f0); MMW(2, 0, f1);
            LDW(3, 1, f1); MMW(2, 1, f2);
            LDQK(0, f2);   MMW(3, 0, f0);
            LDQK(1, f0);   MMW(3, 1, f1);
#pragma unroll
            for (int kt = 0; kt < 4; ++kt)
#pragma unroll
                for (int reg = 0; reg < 16; ++reg) S[kt][reg] *= eg;
            const bf16x8 v00 = pack_lo(vn[0]), v01 = pack_hi(vn[0]), v10 = pack_lo(vn[1]), v11 = pack_hi(vn[1]);
            LDK(0, 0, f1);
            o[0] = MFMA32(f2[0], v00, o[0]); o[1] = MFMA32(f2[1], v00, o[1]); o[1] = MFMA32(f2[2], v10, o[1]); SB_;
            LDK(0, 1, f2);
            o[0] = MFMA32(f0[0], v01, o[0]); o[1] = MFMA32(f0[1], v01, o[1]); o[1] = MFMA32(f0[2], v11, o[1]); SB_;
            LDK(1, 0, f0); MMK(f1, v00);
            LDK(1, 1, f1); MMK(f2, v01);
            MMK(f0, v10); MMK(f1, v11);
#undef LDW
#undef MMW
#undef LDQK
#undef LDK
#undef MMK
#undef SB_
            LAS unsigned char* ob = lds + SC_OB + (c & 1) * OB_BYTES + (32 * w + r) * 2;
#pragma unroll
            for (int mt = 0; mt < 2; ++mt)
#pragma unroll
                for (int reg = 0; reg < 16; reg += 2) { const unsigned pw = pk2(o[mt][reg], o[mt][reg + 1]); *(LAS unsigned short*)(ob + (32 * mt + crow(reg, hh)) * (OB_LD * 2)) = (unsigned short)pw; *(LAS unsigned short*)(ob + (32 * mt + crow(reg + 1, hh)) * (OB_LD * 2)) = (unsigned short)(pw >> 16); }
        } else {
            v4u zn[4];
#pragma unroll
            for (int q = 0; q < 4; ++q) zn[q] = *(const v4u*)(zbase + (size_t)(64 * c) * DM + q * 8);
            if (c + 1 < 32) SCAN_DMA(c + 1, (c + 1) & 1);
            if (c > 0) scan_finish(F, l, b, h, c - 1, lds + SC_OB + ((c - 1) & 1) * OB_BYTES, pf, t4);
#pragma unroll
            for (int q = 0; q < 4; ++q) pf[q] = zn[q];
        }
    }
#undef SCAN_DMA
    asm volatile("s_waitcnt vmcnt(0)" ::: "memory");
    __syncthreads();
    if (w < 4) {
        float* so = F.out + O_SDP + (((size_t)l * NB + b) * NH + h) * HD * HD + 32 * w + r;
#pragma unroll
        for (int kt = 0; kt < 4; ++kt)
#pragma unroll
            for (int reg = 0; reg < 16; ++reg) so[(size_t)(32 * kt + crow(reg, hh)) * HD] = S[kt][reg];
    } else scan_finish(F, l, b, h, 31, lds + SC_OB + (31 & 1) * OB_BYTES, pf, t4);
    __syncthreads();
}

DI void d_units_sample4(Frame& F, int l, int ubase) {
    const int w = F.wave, lane = F.lane, unit = ubase + (w >> 1), half = w & 1, seq = unit >> 3, h = unit & 7;
    const bf16* qc = (const bf16*)(F.ws + WS_QKVS); const float* ab = (const float*)(F.ws + WS_AB);
    const int row0 = TP + seq * TS_, dv = half * 64 + lane;
    LAS unsigned char* wl = F.lds + w * 8192;
    LAS unsigned char* ol = F.lds + 65536 + (w >> 1) * 4096;
    { const int t = lane >> 3, part = (lane >> 2) & 1, ch = lane & 3; const v4u* src = (const v4u*)(qc + (size_t)(row0 - TP + t) * DCONV + part * 1024 + h * HD + ch * 32);
      LAS f32x4* dst = (LAS f32x4*)(wl + t * 1024 + part * 512 + ch * 128);
#pragma unroll
      for (int q = 0; q < 4; ++q) { const v4u a = src[q]; dst[2 * q] = (f32x4){bflo(a.x), bfhi(a.x), bflo(a.y), bfhi(a.y)}; dst[2 * q + 1] = (f32x4){bflo(a.z), bfhi(a.z), bflo(a.w), bfhi(a.w)}; } }
    float gt[8], bt[8], vv[8];
#pragma unroll
    for (int t = 0; t < 8; ++t) { gt[t] = ab[(size_t)(row0 + t) * 16 + h]; bt[t] = ab[(size_t)(row0 + t) * 16 + 8 + h]; vv[t] = pg8::bf2f(qc[(size_t)(row0 - TP + t) * DCONV + 2048 + h * HD + dv]); }
    {
        f32x2_ S[64];
        { const float* s0 = F.in[2] + (((size_t)l * NS + seq) * NH + h) * HD * HD + dv;
#pragma unroll
          for (int k = 0; k < 64; ++k) { S[k].x = __builtin_nontemporal_load(&s0[(size_t)(2 * k) * HD]); S[k].y = __builtin_nontemporal_load(&s0[(size_t)(2 * k + 1) * HD]); } }
#pragma unroll 1
        for (int t = 0; t < TS_; ++t) {
            float g = gt[0], beta = bt[0], vt = vv[0];
#pragma unroll
            for (int i = 1; i < 8; ++i) { if (t == i) { g = gt[i]; beta = bt[i]; vt = vv[i]; } }
            const float e = __expf(g);
            const LAS f32x4* kp = (const LAS f32x4*)(wl + t * 1024 + 512); const LAS f32x4* qp = (const LAS f32x4*)(wl + t * 1024);
            f32x2_ ks2 = (f32x2_){0.f, 0.f};
#pragma unroll
            for (int c = 0; c < 32; ++c) { const f32x4 kw = kp[c]; ks2 = ks2 + (f32x2_){kw.x, kw.y} * S[2 * c]; ks2 = ks2 + (f32x2_){kw.z, kw.w} * S[2 * c + 1];
                if ((c & 7) == 7) asm volatile("" ::: "memory"); }
            const float dlt = beta * (vt - e * (ks2.x + ks2.y));
            f32x2_ o2 = (f32x2_){0.f, 0.f};
#pragma unroll
            for (int c = 0; c < 32; ++c) { const f32x4 kw = kp[c], qw = qp[c];
                S[2 * c] = S[2 * c] * e + (f32x2_){kw.x, kw.y} * dlt; o2 = o2 + (f32x2_){qw.x, qw.y} * S[2 * c];
                S[2 * c + 1] = S[2 * c + 1] * e + (f32x2_){kw.z, kw.w} * dlt; o2 = o2 + (f32x2_){qw.z, qw.w} * S[2 * c + 1];
                if ((c & 3) == 3) asm volatile("" ::: "memory"); }
            *(LAS float*)(ol + (t * 128 + dv) * 4) = o2.x + o2.y;
        }
        float* so = F.out + O_SDS + (((size_t)l * NS + seq) * NH + h) * HD * HD + dv;
#pragma unroll
        for (int k = 0; k < 64; ++k) { __builtin_nontemporal_store(S[k].x, &so[(size_t)(2 * k) * HD]); __builtin_nontemporal_store(S[k].y, &so[(size_t)(2 * k + 1) * HD]); }
    }
    __syncthreads();
    const bf16* z = (const bf16*)(F.ws + WS_Z); bf16* oab = (bf16*)(F.ws + WS_OAB); const float* dnw = F.in[9] + l * HD;
    const float w0 = dnw[2 * lane], w1 = dnw[2 * lane + 1];
    f32x2_ ov[4]; float ss[4]; unsigned zw[4];
#pragma unroll
    for (int k = 0; k < 4; ++k) { const int t = 4 * half + k; ov[k] = *(const LAS f32x2_*)(ol + (t * 128 + 2 * lane) * 4); ss[k] = ov[k].x * ov[k].x + ov[k].y * ov[k].y; zw[k] = *(const unsigned*)(z + (size_t)(row0 + t) * DM + h * HD + 2 * lane); }
    wave_sum_n<4>(ss);
#pragma unroll
    for (int k = 0; k < 4; ++k) { const int t = 4 * half + k; const float rs = rsq_(ss[k] * (1.0f / HD) + 1e-6f);
        *(unsigned*)(oab + (size_t)(row0 + t) * LD_OAB + h * HD + 2 * lane) = pk2(ov[k].x * rs * w0 * siluf_(bflo(zw[k])), ov[k].y * rs * w1 * siluf_(bfhi(zw[k]))); }
    __syncthreads();
}
constexpr int CL_ST = 0, CL_VT = 1024, VT_LD = 136, CL_MX = 1024 + 128 * 136 * 2, MX_LD = 132;
DI void cmlp_unit(Frame& F, int l, int ck) {
    const int w = F.wave, lane = F.lane, row0 = 128 * ck;
    LAS unsigned char* lds = F.lds;
    const bf16* uv = (const bf16*)(F.ws + WS_UV); bf16* oab = (bf16*)(F.ws + WS_OAB);
    const float* lw = F.in[10] + l * DB; const float* lb = F.in[11] + l * DB; const float* bsp = F.in[13] + (size_t)l * NH * 128;
    const bf16* wsp = (const bf16*)(F.ws + WS_W + (size_t)l * W_LAYER + W_SP);
    const bool lastck = (ck & 15) == 15;
#pragma unroll 1
    for (int rb = 0; rb < 4; ++rb) {
        f32x4 v[4][4]; float sm[4], sq[4];
#pragma unroll
        for (int k = 0; k < 4; ++k) { const int row = row0 + 16 * w + 4 * rb + k; sm[k] = 0.f;
#pragma unroll
            for (int j = 0; j < 4; ++j) { const v2u u = *((const v2u*)(uv + (size_t)row * 2048 + 1024) + lane + 64 * j); v[k][j] = (f32x4){bflo(u.x), bfhi(u.x), bflo(u.y), bfhi(u.y)}; sm[k] += (v[k][j].x + v[k][j].y) + (v[k][j].z + v[k][j].w); } }
        wave_sum_n<4>(sm);
#pragma unroll
        for (int k = 0; k < 4; ++k) { const float mean = sm[k] * (1.0f / DB); sm[k] = mean; sq[k] = 0.f;
#pragma unroll
            for (int j = 0; j < 4; ++j) { v[k][j] = v[k][j] - mean; sq[k] += (v[k][j].x * v[k][j].x + v[k][j].y * v[k][j].y) + (v[k][j].z * v[k][j].z + v[k][j].w * v[k][j].w); } }
        wave_sum_n<4>(sq);
#pragma unroll
        for (int k = 0; k < 4; ++k) { const int i = 16 * w + 4 * rb + k; const float rstd = rsq_(sq[k] * (1.0f / DB) + 1e-5f);
            if (lane == 0) { ((LAS float*)(lds + CL_ST))[2 * i] = sm[k]; ((LAS float*)(lds + CL_ST))[2 * i + 1] = rstd; }
            if (lastck) { float* cvo = F.out + O_CVP + (((size_t)l * NB + (ck >> 4)) * 128 + i) * DB;
#pragma unroll
                for (int j = 0; j < 4; ++j) { const f32x4 ww = ((const f32x4*)lw)[lane + 64 * j], bb = ((const f32x4*)lb)[lane + 64 * j]; __builtin_nontemporal_store(v[k][j] * rstd * ww + bb, ((f32x4*)cvo) + lane + 64 * j); } } }
    }
    __syncthreads();
    const int r = lane & 31, hh = lane >> 5, nt = w & 3, mta = (w >> 2) ? 1 : 0, mtb = 3 - mta;
    const int erow = F.tid >> 2, eseg = F.tid & 3;
    unsigned va[8], vb[8];
#define CMLP_VLOAD(g_) do { const int ch_ = (g_) * 128 + 2 * lane; _Pragma("unroll") for (int pr = 0; pr < 8; ++pr) { const int j_ = 16 * w + 2 * pr; \
        va[pr] = *(const unsigned*)(uv + (size_t)(row0 + j_) * 2048 + 1024 + ch_); vb[pr] = *(const unsigned*)(uv + (size_t)(row0 + j_ + 1) * 2048 + 1024 + ch_); } } while (0)
    CMLP_VLOAD(0);
#pragma unroll 1
    for (int g = 0; g < 8; ++g) {
        const bf16* wg = wsp + (size_t)g * 128 * 128;
        bf16x8 wa[4], wb[8];
#pragma unroll
        for (int ks = 0; ks < 4; ++ks) wa[ks] = *(const bf16x8*)(wg + (size_t)(32 * mta + r) * 128 + 16 * ks + 8 * hh);
#pragma unroll
        for (int ks = 0; ks < 8; ++ks) wb[ks] = *(const bf16x8*)(wg + (size_t)(32 * mtb + r) * 128 + 16 * ks + 8 * hh);
        const size_t eoff = (size_t)(row0 + erow) * 2048 + g * 128 + eseg * 32;
        v4u uu[4];
#pragma unroll
        for (int q = 0; q < 4; ++q) uu[q] = *(const v4u*)(uv + eoff + q * 8);
        { const int ch = g * 128 + 2 * lane; const float w0 = lw[ch], w1 = lw[ch + 1], b0 = lb[ch], b1 = lb[ch + 1];
#pragma unroll
          for (int pr = 0; pr < 8; ++pr) { const int j = 16 * w + 2 * pr; const unsigned ua = va[pr], ub = vb[pr];
            const f32x4 st = *(const LAS f32x4*)(lds + CL_ST + j * 8);
            const float a0 = (bflo(ua) - st.x) * st.y * w0 + b0, a1 = (bfhi(ua) - st.x) * st.y * w1 + b1, c0 = (bflo(ub) - st.z) * st.w * w0 + b0, c1 = (bfhi(ub) - st.z) * st.w * w1 + b1;
            *(LAS unsigned*)(lds + CL_VT + ((2 * lane) * VT_LD + j) * 2) = pk2(a0, c0);
            *(LAS unsigned*)(lds + CL_VT + ((2 * lane + 1) * VT_LD + j) * 2) = pk2(a1, c1); } }
        if (g + 1 < 8) CMLP_VLOAD(g + 1);
        __syncthreads();
        f32x16 acc[2]; acc[0] = zero16(); acc[1] = zero16();
#pragma unroll
        for (int ks = 0; ks < 8; ++ks) {
            const bf16x8 bfr = lds_frag(lds + CL_VT + ((32 * nt + r) * VT_LD + 16 * ks + 8 * hh) * 2);
            if (ks < 4) acc[0] = MFMA32(wa[ks], bfr, acc[0]);
            acc[1] = MFMA32(wb[ks], bfr, acc[1]);
        }
#pragma unroll
        for (int t2 = 0; t2 < 2; ++t2) { const int mt = t2 ? mtb : mta;
#pragma unroll
            for (int reg = 0; reg < 16; ++reg) { const int i = 32 * mt + crow(reg, hh); *(LAS float*)(lds + CL_MX + (i * MX_LD + 32 * nt + r) * 4) = acc[t2][reg] + bsp[g * 128 + i]; } }
        __syncthreads();
#pragma unroll
        for (int q = 0; q < 4; ++q) { const f32x4 m0 = *(const LAS f32x4*)(lds + CL_MX + (erow * MX_LD + eseg * 32 + q * 8) * 4), m1 = *(const LAS f32x4*)(lds + CL_MX + (erow * MX_LD + eseg * 32 + q * 8 + 4) * 4);
            v4u o; o.x = pk2(bflo(uu[q].x) * m0.x, bfhi(uu[q].x) * m0.y); o.y = pk2(bflo(uu[q].y) * m0.z, bfhi(uu[q].y) * m0.w); o.z = pk2(bflo(uu[q].z) * m1.x, bfhi(uu[q].z) * m1.y); o.w = pk2(bflo(uu[q].w) * m1.z, bfhi(uu[q].w) * m1.w);
            *(v4u*)(oab + (size_t)(row0 + erow) * LD_OAB + 1024 + g * 128 + eseg * 32 + q * 8) = o; }
    }
#undef CMLP_VLOAD
    __syncthreads();
}
DI void cmlp_sample_unit(Frame& F, int l, int n, int jq) {
    const int lane = F.lane, row0 = TP + n * TS_;
    const bf16* uv = (const bf16*)(F.ws + WS_UV); bf16* oab = (bf16*)(F.ws + WS_OAB);
    const float* lw = F.in[10] + l * DB; const float* lb = F.in[11] + l * DB; const float* bsp = F.in[13] + (size_t)l * NH * 128; const float* wsp = F.in[12] + (size_t)l * NH * 128 * 128;
    v2u raw[8][4];
#pragma unroll
    for (int t = 0; t < 8; ++t)
#pragma unroll
        for (int j = 0; j < 4; ++j) raw[t][j] = *((const v2u*)(uv + (size_t)(row0 + t) * 2048 + 1024) + lane + 64 * j);
    v2u uu[8];
#pragma unroll
    for (int t = 0; t < 8; ++t) uu[t] = *(const v2u*)(uv + (size_t)(row0 + t) * 2048 + 4 * lane + 256 * jq);
    const int g = 2 * jq + (lane >> 5);
    float wm[8][8];
#pragma unroll
    for (int i = 0; i < 8; ++i)
#pragma unroll
        for (int jj = 0; jj <= i; ++jj) wm[i][jj] = wsp[((size_t)g * 128 + i) * 128 + jj];
    float sm[8], sq[8];
#pragma unroll
    for (int t = 0; t < 8; ++t) { sm[t] = 0.f;
#pragma unroll
        for (int j = 0; j < 4; ++j) sm[t] += (bflo(raw[t][j].x) + bfhi(raw[t][j].x)) + (bflo(raw[t][j].y) + bfhi(raw[t][j].y)); }
    wave_sum_n<8>(sm);
#pragma unroll
    for (int t = 0; t < 8; ++t) { const float mean = sm[t] * (1.0f / DB); sm[t] = mean; sq[t] = 0.f;
#pragma unroll
        for (int j = 0; j < 4; ++j) { const float a = bflo(raw[t][j].x) - mean, b2 = bfhi(raw[t][j].x) - mean, c = bflo(raw[t][j].y) - mean, d = bfhi(raw[t][j].y) - mean; sq[t] += (a * a + b2 * b2) + (c * c + d * d); } }
    wave_sum_n<8>(sq);
    const f32x4 ww = ((const f32x4*)lw)[lane + 64 * jq], bb = ((const f32x4*)lb)[lane + 64 * jq];
    f32x4 vn[8];
#pragma unroll
    for (int t = 0; t < 8; ++t) { const float rstd = rsq_(sq[t] * (1.0f / DB) + 1e-5f), mean = sm[t];
        f32x4 v;
        if (jq == 0) v = (f32x4){bflo(raw[t][0].x), bfhi(raw[t][0].x), bflo(raw[t][0].y), bfhi(raw[t][0].y)};
        else if (jq == 1) v = (f32x4){bflo(raw[t][1].x), bfhi(raw[t][1].x), bflo(raw[t][1].y), bfhi(raw[t][1].y)};
        else if (jq == 2) v = (f32x4){bflo(raw[t][2].x), bfhi(raw[t][2].x), bflo(raw[t][2].y), bfhi(raw[t][2].y)};
        else v = (f32x4){bflo(raw[t][3].x), bfhi(raw[t][3].x), bflo(raw[t][3].y), bfhi(raw[t][3].y)};
        vn[t] = (v - mean) * rstd * ww + bb;
        ((f32x4*)(F.out + O_CVS + (((size_t)l * NS + n) * TS_ + t) * DB))[lane + 64 * jq] = vn[t]; }
#pragma unroll
    for (int i = 0; i < 8; ++i) { f32x4 m = (f32x4){0.f, 0.f, 0.f, 0.f};
#pragma unroll
        for (int jj = 0; jj <= i; ++jj) m = m + vn[jj] * wm[i][jj];
        m = m + bsp[g * 128 + i];
        v2u o; o.x = pk2(bflo(uu[i].x) * m.x, bfhi(uu[i].x) * m.y); o.y = pk2(bflo(uu[i].y) * m.z, bfhi(uu[i].y) * m.w);
        *(v2u*)(oab + (size_t)(row0 + i) * LD_OAB + 1024 + 4 * lane + 256 * jq) = o; }
}
DI void d_phase(Frame& F, int l) {
    constexpr int NU = NS * NH, U_SB = 512;
    if (F.bid < NB * NH) { scan_unit(F, l, F.bid); return; }
    if (F.bid < NB * NH + 128) { const int cb = F.bid - NB * NH; cmlp_unit(F, l, cb);
        for (int ub = U_SB + 4 * cb; ub < NU; ub += 4 * 128) d_units_sample4(F, l, ub);
        if (l == 0) tr_range(F, I_L, I_L + WT_CM, cb * NWAVES + F.wave, 128 * NWAVES);
        return; }
    const int sb = F.bid - NB * NH - 128, nsb = F.G - NB * NH - 128;
    for (int ub = 4 * sb; ub < U_SB; ub += 4 * nsb) d_units_sample4(F, l, ub);
    const int gw = sb * NWAVES + F.wave, NGW = nsb * NWAVES;
    for (int u = gw; u < NS * 4; u += NGW) cmlp_sample_unit(F, l, u >> 2, u & 3);
    if (l == 0) { __syncthreads(); tr_range(F, I_L + WT_CM, 2 * I_L - WT_DEFER, gw, NGW); }
    else if (l == 1) { __syncthreads(); tr_range(F, 2 * I_L - WT_DEFER, 2 * I_L, gw, NGW); }
}
typedef float f32x4_ __attribute__((ext_vector_type(4)));
DI void tail_gemm(Frame& F, int kind, const bf16* A, const bf16* Bt, int K, int lda, int ldb, size_t yoff) {
    const int w = F.wave, lane = F.lane, t = F.bid, idx = t >> 4, sub = t & 15;
    const int row0 = TP + 256 * (idx >> 2) + 64 * (sub >> 2), col0 = 256 * (idx & 3) + 64 * (sub & 3);
    const int kw = K >> 3, nks = kw >> 5, l15 = lane & 15, lq = lane >> 4;
    const bf16* ap = A + (size_t)(row0 + l15) * lda + w * kw + 8 * lq;
    const bf16* bp = Bt + (size_t)(col0 + l15) * ldb + w * kw + 8 * lq;
    f32x4_ acc[4][4];
#pragma unroll
    for (int mi = 0; mi < 4; ++mi)
#pragma unroll
        for (int ni = 0; ni < 4; ++ni) acc[mi][ni] = (f32x4_){0.f, 0.f, 0.f, 0.f};
#pragma unroll 1
    for (int k0 = 0; k0 < nks; k0 += 4) {
        bf16x8 fa[4][4], fb[4][4];
#pragma unroll
        for (int kk = 0; kk < 4; ++kk) { const int ko = (k0 + kk < nks) ? 32 * (k0 + kk) : 0;
#pragma unroll
            for (int q = 0; q < 4; ++q) { fa[kk][q] = *(const bf16x8*)(ap + (size_t)(16 * q) * lda + ko); fb[kk][q] = *(const bf16x8*)(bp + (size_t)(16 * q) * ldb + ko); } }
#pragma unroll
        for (int kk = 0; kk < 4; ++kk) { if (k0 + kk < nks) {
#pragma unroll
            for (int mi = 0; mi < 4; ++mi)
#pragma unroll
                for (int ni = 0; ni < 4; ++ni) acc[mi][ni] = __builtin_amdgcn_mfma_f32_16x16x32_bf16(fa[kk][mi], fb[kk][ni], acc[mi][ni], 0, 0, 0); } }
    }
    LAS float* pl = (LAS float*)(F.lds + w * 16384);
#pragma unroll
    for (int mi = 0; mi < 4; ++mi)
#pragma unroll
        for (int ni = 0; ni < 4; ++ni)
#pragma unroll
            for (int rg = 0; rg < 4; ++rg) pl[(16 * mi + 4 * lq + rg) * 64 + 16 * ni + l15] = acc[mi][ni][rg];
    __syncthreads();
    const int er = F.tid >> 3, ec = (F.tid & 7) * 8;
    f32x4_ s0[2], s1[2]; s0[0] = s0[1] = s1[0] = s1[1] = (f32x4_){0.f, 0.f, 0.f, 0.f};
#pragma unroll
    for (int ww = 0; ww < 8; ++ww) { const LAS f32x4_* p = (const LAS f32x4_*)(F.lds + ww * 16384 + (er * 64 + ec) * 4);
        if (ww < 4) { s0[0] = s0[0] + p[0]; s0[1] = s0[1] + p[1]; } else { s1[0] = s1[0] + p[0]; s1[1] = s1[1] + p[1]; } }
    float o[8];
    if (kind == 1) {
        const bf16* gt = (const bf16*)(F.ws + WS_GT) + (size_t)(row0 + er) * 2048 + col0 + ec;
        const v4u gaw = *(const v4u*)gt, gbw = *(const v4u*)(gt + 1024);
#pragma unroll
        for (int e = 0; e < 4; ++e) { const float a0 = bflo(gaw[e]), a1 = bfhi(gaw[e]), b0 = bflo(gbw[e]), b1 = bfhi(gbw[e]);
            o[2 * e] = sigmoidf_(a0) * s0[e >> 1][(2 * e) & 3] + sigmoidf_(b0) * s1[e >> 1][(2 * e) & 3];
            o[2 * e + 1] = sigmoidf_(a1) * s0[e >> 1][(2 * e + 1) & 3] + sigmoidf_(b1) * s1[e >> 1][(2 * e + 1) & 3]; }
    } else {
#pragma unroll
        for (int e = 0; e < 8; ++e) o[e] = s0[e >> 2][e & 3] + s1[e >> 2][e & 3];
    }
    bf16* dst = (bf16*)(F.ws + (kind == 1 ? WS_MERGED : WS_Y + yoff)) + (size_t)(row0 + er) * DM + col0 + ec;
    *(v4u*)dst = (v4u){pk2(o[0], o[1]), pk2(o[2], o[3]), pk2(o[4], o[5]), pk2(o[6], o[7])};
    __syncthreads();
}

#define XB_TMO      128
#define XB_XCNT(j)  (256  + 64 * (j))
#define XB_XSUB(j)  (1280 + 64 * (j))
#define XB_XGEN(j)  (2304 + 64 * (j))
#define XB_TOP      3328
#define XB_TOPGEN   3392
#define XCD_BAR_WORDS 3456
#define XB_SPIN_CAP (1u << 22)
__device__ __forceinline__ unsigned xb_ld(unsigned* p)              { return __hip_atomic_load(p, __ATOMIC_RELAXED, __HIP_MEMORY_SCOPE_AGENT); }
__device__ __forceinline__ unsigned xb_add(unsigned* p, unsigned v) { return __hip_atomic_fetch_add(p, v, __ATOMIC_RELAXED, __HIP_MEMORY_SCOPE_AGENT); }
__device__ __forceinline__ unsigned xb_xcc_id() { return (unsigned)__builtin_amdgcn_s_getreg((3 << 11) | 20) & 0xFu; }
#define XB_SPIN(cond, bar) do { unsigned _sp = 0; while (cond) { __builtin_amdgcn_s_sleep(1); \
    if ((++_sp & 255u) == 0u) { if (xb_ld(&(bar)[XB_TMO])) break; if (_sp > XB_SPIN_CAP) { atomicAdd(&(bar)[XB_TMO], 1u); break; } } } } while (0)
struct XcdBarrier { unsigned* bar; unsigned x; volatile LAS unsigned* st; };
__device__ __forceinline__ XcdBarrier xcd_barrier_post(unsigned* bar, volatile LAS unsigned* st) {
    XcdBarrier b; b.bar = bar; b.x = xb_xcc_id(); b.st = st;
    if (threadIdx.x == 0) (void)xb_add(&bar[XB_XCNT(b.x)], 1u);
    return b;
}
__device__ __forceinline__ void xcd_barrier_complete(unsigned* bar, unsigned x, unsigned& nloc, unsigned& nx) {
    const unsigned G = gridDim.x * gridDim.y * gridDim.z;
    unsigned sum, cnt, mine, sp = 0u;
    for (;;) {
        sum = 0u; cnt = 0u; mine = 0u;
#pragma unroll 1
        for (unsigned j = 0; j < 16; ++j) { const unsigned c = xb_ld(&bar[XB_XCNT(j)]); sum += c; cnt += (c > 0u) ? 1u : 0u; mine = (j == x) ? c : mine; }
        if (sum == G) break;
        __builtin_amdgcn_s_sleep(1);
        if ((++sp & 255u) == 0u) { if (xb_ld(&bar[XB_TMO])) break; if (sp > XB_SPIN_CAP) { atomicAdd(&bar[XB_TMO], 1u); break; } }
    }
    nloc = mine > 0u ? mine : 1u; nx = cnt > 0u ? cnt : 1u;
}
__device__ __forceinline__ void xcd_barrier(const XcdBarrier& b) {
    asm volatile("s_waitcnt vmcnt(0)" ::: "memory");
    __syncthreads();
    if (threadIdx.x == 0) {
        unsigned* bar = b.bar; asm volatile("" : "+s"(bar));
        __builtin_amdgcn_s_waitcnt(0);
        unsigned nloc = b.st[0], nx = b.st[1];
        if (nloc == 0u) { xcd_barrier_complete(bar, b.x, nloc, nx); b.st[0] = nloc; b.st[1] = nx; }
        asm volatile("buffer_inv sc1" ::: "memory");
        const unsigned old = xb_add(&bar[XB_XSUB(b.x)], 1u);
        const unsigned gen = old / nloc;
        if (old + 1u == (gen + 1u) * nloc) {
            __builtin_amdgcn_fence(__ATOMIC_RELEASE, "agent");
            asm volatile("s_waitcnt vmcnt(0)" ::: "memory");
            const unsigned og = xb_add(&bar[XB_TOP], 1u);
            const unsigned tg = og / nx;
            if (og + 1u == (tg + 1u) * nx) xb_add(&bar[XB_TOPGEN], 1u);
            else XB_SPIN(xb_ld(&bar[XB_TOPGEN]) == tg, bar);
            asm volatile("" ::: "memory");
            xb_add(&bar[XB_XGEN(b.x)], 1u);
            asm volatile("s_waitcnt vmcnt(0)" ::: "memory");
        } else {
            XB_SPIN(xb_ld(&bar[XB_XGEN(b.x)]) == gen, bar);
            asm volatile("s_waitcnt vmcnt(0)" ::: "memory");
        }
    }
    __syncthreads();
}

constexpr int PH_PER_LAYER = 9, N_PHASES = 1 + DEPTH * PH_PER_LAYER;
__global__ void __launch_bounds__(NWAVES * 64, 2) mega_fwd(Args args) {
    extern __shared__ __attribute__((aligned(16))) unsigned char lds_raw[];
    Frame F; F.lds = (LAS unsigned char*)lds_raw; F.tid = threadIdx.x; F.lane = F.tid & 63; F.wave = __builtin_amdgcn_readfirstlane(F.tid >> 6);
    F.G = gridDim.x; F.bid = blockIdx.x; F.out = args.out; F.ws = args.ws;
#if MK_ONE_LAUNCH
    if (threadIdx.x < 16) ((LAS unsigned*)(F.lds + LDS_BYTES - 64))[threadIdx.x] = 0u;
    __syncthreads();
    const XcdBarrier xbar = xcd_barrier_post((unsigned*)(args.ws + WS_CTL) + 4096, (volatile LAS unsigned*)(F.lds + LDS_BYTES - 64));
#define SEAM(k) do { if ((k) + 1 < hi) xcd_barrier(xbar); } while (0)
#else
#define SEAM(k) do { } while (0)
#endif
#ifndef PH_MASK
#define PH_MASK 0x7ff
#endif
#define EN(j) ((PH_MASK >> (j)) & 1)
    int lo = args.ph_lo; const int hi = args.ph_hi;
    unsigned char* ws = args.ws;
    if (lo == 0) {
        { __attribute__((address_space(1))) unsigned char* w_ = (__attribute__((address_space(1))) unsigned char*)args.ws; asm volatile("" : "+s"(w_)); F.ws = (unsigned char*)w_; }
        if (EN(10)) { float a_[32], b_[32]; wab_issue(F, 0, a_, b_); p0_weights(F); wab_commit(F, a_, b_); p0_rows(F); }
#if MK_ONE_LAUNCH
        if (hi > 1) xcd_barrier(xbar);
#endif
        lo = 1;
    }
#pragma unroll 1
    for (int p = lo; p < hi; ++p) {
        { __attribute__((address_space(1))) unsigned char* w_ = (__attribute__((address_space(1))) unsigned char*)args.ws; __attribute__((address_space(1))) float* o_ = (__attribute__((address_space(1))) float*)args.out;
          int t_ = threadIdx.x; asm volatile("" : "+s"(w_), "+s"(o_), "+v"(t_)); ws = (unsigned char*)w_; F.ws = (unsigned char*)w_; F.out = (float*)o_;
          F.tid = t_; F.lane = t_ & 63; F.wave = __builtin_amdgcn_readfirstlane(t_ >> 6); }
        {
            const int l = (p - 1) / PH_PER_LAYER, j = (p - 1) % PH_PER_LAYER;
            int gk = -1;
#define REOPQ() do { __attribute__((address_space(1))) unsigned char* w__ = (__attribute__((address_space(1))) unsigned char*)args.ws; asm volatile("" : "+s"(w__)); F.ws = (unsigned char*)w__; ws = (unsigned char*)w__; } while (0)
            if (j == 0 || j == 3 || j == 4 || j == 6 || j == 7) gk = j;
            else if (j == 1) { REOPQ(); if (EN(1)) prep_phase(F, l); }
            else if (j == 2) { REOPQ(); if (EN(2)) d_phase(F, l); }
            else if (EN(5)) { REOPQ(); const bool r1 = (j == 5); rows_residual(F, (const bf16*)(ws + WS_Y + (r1 ? 0 : Y2_OFF)), (r1 ? F.in[17] : F.in[21]) + l * DM, r1 ? (const bf16*)nullptr : (const bf16*)(ws + WS_Y), F.in[17] + l * DM,
                                                                                         l == 0, !r1 && l == DEPTH - 1, !r1, r1 ? -1 : l + 1); }
            if (EN(0) && gk >= 0) {
                REOPQ(); unsigned char* wl = ws + WS_W + (size_t)l * W_LAYER;
                pg8::Gemm g; pg8::EpiAny E; E.mid_t = -1; E.ws = ws; E.yoff = 0;
                if (gk == 0)      { g = pg8::Gemm{(const bf16*)(ws + WS_XB), (const bf16*)(wl + W_IN), TT, 8192, DM, DM, DM}; E.kind = 0; }
                else if (gk == 3) { g = pg8::Gemm{(const bf16*)(ws + WS_OAB), (const bf16*)(wl + W_PAB), TT, DM, 2048, LD_OAB, LD_PAB}; E.kind = 1; E.mid_t = 16; }
                else if (gk == 4) { g = pg8::Gemm{(const bf16*)(ws + WS_MERGED), (const bf16*)(wl + W_OUT), TT, DM, DM, DM, DM}; E.kind = 2; }
                else if (gk == 6) { g = pg8::Gemm{(const bf16*)(ws + WS_XB), (const bf16*)(wl + W_FIN), TT, 2 * DFF, DM, DM, DM}; E.kind = 3; }
                else              { g = pg8::Gemm{(const bf16*)(ws + WS_H), (const bf16*)(wl + W_FOUT), TT, DM, DFF, DFF, DFF}; E.kind = 2; E.yoff = Y2_OFF; }
                const bool n1k = (g.N == DM);
                if (n1k) g.M = TP;
                pg8::StaticOrder S; S.init(g.M, g.N, F.G, F.bid); S.pmaj = n1k ? 1 : 0;
                const bool tf = n1k && ((F.bid >> 3) & 1);
                if (tf) tail_gemm(F, E.kind, g.A, g.Bt, g.K, g.lda, g.ldb, E.yoff);
                pg8::gemm_phase<pg8::EpiAny, pg8::StaticOrder, true, true>(F.lds, g, S, E);
                if (n1k && !tf) tail_gemm(F, E.kind, g.A, g.Bt, g.K, g.lda, g.ldb, E.yoff);
            }
        }
        SEAM(p);
    }
#undef SEAM
}

extern "C" void kernel_launch(void* const* d_in, const int* in_sizes, int n_in, void* d_out, int out_size, void* d_ws, size_t ws_size, hipStream_t stream) {
    static int grid = 0;
    if (grid == 0) {
        if (n_in != 22 || (size_t)out_size != O_END || ws_size < WS_END) { fprintf(stderr, "kernel_launch: unexpected shapes: n_in %d out %d (want %zu) ws %zu (need %zu)\n", n_in, out_size, (size_t)O_END, ws_size, (size_t)WS_END); grid = -1; return; }
        int dev = 0, cus = 0, per_cu = 0;
        if (hipGetDevice(&dev) != hipSuccess || hipDeviceGetAttribute(&cus, hipDeviceAttributeMultiprocessorCount, dev) != hipSuccess) { grid = -1; return; }
        if (hipFuncSetAttribute((const void*)mega_fwd, hipFuncAttributeMaxDynamicSharedMemorySize, LDS_BYTES) != hipSuccess) { fprintf(stderr, "kernel_launch: hipFuncSetAttribute failed\n"); grid = -1; return; }
        if (hipOccupancyMaxActiveBlocksPerMultiprocessor(&per_cu, (const void*)mega_fwd, NWAVES * 64, LDS_BYTES) != hipSuccess || per_cu < 1) { fprintf(stderr, "kernel_launch: occupancy query says %d\n", per_cu); per_cu = 1; }
        (void)hipGetLastError();
        grid = cus;
        if (grid != 256) { fprintf(stderr, "kernel_launch: this kernel is laid out for a 256-CU device (got %d)\n", grid); grid = -1; return; }
    }
    if (grid < 0) return;
    Args a{};
    for (int i = 0; i < 22; ++i) a.in[i] = (const float*)d_in[i];
    a.out = (float*)d_out; a.ws = (unsigned char*)d_ws;
#if MK_ONE_LAUNCH
    if (hipMemsetAsync((char*)d_ws + WS_CTL, 0, 64 * 1024, stream) != hipSuccess) { fprintf(stderr, "kernel_launch: memset failed\n"); return; }
    a.ph_lo = 0; a.ph_hi = N_PHASES;
    void* kargs[] = {&a};
    hipError_t e = hipLaunchCooperativeKernel((void*)mega_fwd, dim3(grid), dim3(NWAVES * 64), kargs, LDS_BYTES, stream);
    if (e != hipSuccess) fprintf(stderr, "cooperative launch failed: %s (grid %d)\n", hipGetErrorString(e), grid);
#else
    for (int p = 0; p < N_PHASES; ++p) { a.ph_lo = p; a.ph_hi = p + 1; hipLaunchKernelGGL(mega_fwd, dim3(grid), dim3(NWAVES * 64), LDS_BYTES, stream, a); }
#endif
}
```
